# Optimizing an MI355X kernel written in HIP

```python
import math
import jax, jax.numpy as jnp
from jax import lax
import numpy as np

D_MODEL = 2048
BATCH = 1
SEQ = 16384
DEPTH = 4

GRID_W = 64
CTX_LEN = 256
N_MIXERS = 4
MIX_FOURIER, MIX_CONV, MIX_ATTN, MIX_SSM = 0, 1, 2, 3
FOURIER_GROUPS = 8
FOURIER_GROUP_DIM = D_MODEL // FOURIER_GROUPS
CONV_WIDTH = 3
HEAD_DIM = 128
N_HEADS = D_MODEL // HEAD_DIM
N_KV_HEADS = 4
Q_PER_KV = N_HEADS // N_KV_HEADS
ROPE_AXIS_PAIRS = HEAD_DIM // 4
ROPE_THETA = 10000.0
Q_BLOCK = 128
SSM_GROUP_DIM = 16
SSM_GROUPS = D_MODEL // SSM_GROUP_DIM
SSM_STATE = 64
SSM_CHUNK = 128
DT_MIN = 1e-3
DT_MAX = 1e-1
N_EXPERTS = 32
TOP_K = 4
D_EXPERT = 1024
SWIGLU_LIMIT = 7.0
SWIGLU_ALPHA = 1.702
MOE_BLOCK = 256
NORM_EPS = 1e-6

kernel_name = 'hybrid_interleaved_diffusion_moe_block'


def _mixer_layers(m):
    return len(range(m, DEPTH, N_MIXERS))


def _rmsnorm(x, g):
    xf = x.astype(jnp.float32)
    y = xf * lax.rsqrt(jnp.mean(xf * xf, axis=-1, keepdims=True) + NORM_EPS)
    return (y * g.astype(jnp.float32)).astype(x.dtype)


def _modulate(x, g, shift, scale):
    return _rmsnorm(x, g) * (1 + scale) + shift


def _split_mod(cond, w, b):
    return jnp.split(jax.nn.silu(cond) @ w + b, 6, axis=-1)


def _fourier_mix(h, hc, w_out, b_out):
    def mix(u):
        bsz, n, _ = u.shape
        ug = u.astype(jnp.float32).reshape(bsz, n, FOURIER_GROUPS, FOURIER_GROUP_DIM)
        f = jnp.fft.fft2(ug, axes=(1, 3), norm='ortho').real
        return f.reshape(bsz, n, D_MODEL).astype(u.dtype) @ w_out + b_out
    return mix(h), (None if hc is None else mix(hc))


def _short_conv_mix(h, hc, w_in, conv_k, conv_b, w_out):
    def mix(u):
        gate_b, gate_c, v = jnp.split(u @ w_in, 3, axis=-1)
        z = lax.conv_general_dilated(
            gate_c * v, conv_k[:, None, :], window_strides=(1,),
            padding=((CONV_WIDTH // 2, CONV_WIDTH // 2),),
            dimension_numbers=('NWC', 'WIO', 'NWC'), feature_group_count=D_MODEL) + conv_b
        return (gate_b * z) @ w_out
    return mix(h), (None if hc is None else mix(hc))


def _axial_rope_tables(n):
    rows = n // GRID_W
    r = jnp.repeat(jnp.arange(rows, dtype=jnp.float32), GRID_W)
    col = jnp.tile(jnp.arange(GRID_W, dtype=jnp.float32), rows)
    inv = ROPE_THETA ** (-jnp.arange(ROPE_AXIS_PAIRS, dtype=jnp.float32) / ROPE_AXIS_PAIRS)
    ang = jnp.concatenate([r[:, None] * inv, col[:, None] * inv], axis=-1)
    return jnp.cos(ang), jnp.sin(ang)


def _apply_rope(x, cos, sin):
    xf = x.astype(jnp.float32)
    x1, x2 = xf[..., :HEAD_DIM // 2], xf[..., HEAD_DIM // 2:]
    cs, sn = cos[None, :, None, :], sin[None, :, None, :]
    return jnp.concatenate([x1 * cs - x2 * sn, x2 * cs + x1 * sn], axis=-1).astype(x.dtype)


def _attend(q, k, v):
    s = jnp.einsum('bqngd,bsnd->bngqs', q, k).astype(jnp.float32) * HEAD_DIM ** -0.5
    p = jax.nn.softmax(s, axis=-1).astype(v.dtype)
    return jnp.einsum('bngqs,bsnd->bqngd', p, v)


def _gqa_mix(h, hc, wq, wk, wv, wo, q_g, k_g, ctx_out):
    bsz, n, _ = h.shape

    def proj_q(u):
        return _rmsnorm((u @ wq).reshape(u.shape[0], u.shape[1], N_HEADS, HEAD_DIM), q_g)

    def proj_kv(u):
        k = _rmsnorm((u @ wk).reshape(u.shape[0], u.shape[1], N_KV_HEADS, HEAD_DIM), k_g)
        v = (u @ wv).reshape(u.shape[0], u.shape[1], N_KV_HEADS, HEAD_DIM)
        return k, v

    cos, sin = _axial_rope_tables(n)
    q = _apply_rope(proj_q(h), cos, sin).reshape(bsz, n // Q_BLOCK, Q_BLOCK, N_KV_HEADS, Q_PER_KV, HEAD_DIM)
    k, v = proj_kv(h)
    k = _apply_rope(k, cos, sin)
    kc, vc = proj_kv(hc)
    k_all = jnp.concatenate([k, kc], axis=1)
    v_all = jnp.concatenate([v, vc], axis=1)
    o = lax.map(lambda qb: _attend(qb, k_all, v_all), jnp.moveaxis(q, 1, 0))
    y = jnp.moveaxis(o, 0, 1).reshape(bsz, n, N_HEADS * HEAD_DIM) @ wo
    if not ctx_out:
        return y, None
    m = hc.shape[1]
    qc = proj_q(hc).reshape(bsz, m, N_KV_HEADS, Q_PER_KV, HEAD_DIM)
    yc = _attend(qc, kc, vc).reshape(bsz, m, N_HEADS * HEAD_DIM) @ wo
    return y, yc


def _s5_discretise(a_re, a_im, log_dt, b_re, b_im, c_re, c_im):
    f = jnp.float32
    a = lax.complex(a_re.astype(f), a_im.astype(f))
    a_bar = jnp.exp(a * jnp.exp(log_dt.astype(f))[:, None])
    b_bar = ((a_bar - 1) / a)[..., None] * lax.complex(b_re.astype(f), b_im.astype(f))
    c_mat = lax.complex(c_re.astype(f), c_im.astype(f))
    return a_bar, b_bar, c_mat


def _linear_recurrence(e1, e2):
    a1, b1 = e1
    a2, b2 = e2
    return a1 * a2, a2 * b1 + b2


def _s5_scan(u, h0, a_bar, b_bar, c_mat, with_y):
    bsz, n, _ = u.shape
    uc = u.astype(jnp.float32).reshape(bsz, n // SSM_CHUNK, SSM_CHUNK, SSM_GROUPS, SSM_GROUP_DIM)

    def step(h, u_blk):
        bu = jnp.einsum('blgc,gpc->blgp', u_blk.astype(jnp.complex64), b_bar)
        bu = bu.at[:, 0].add(a_bar * h)
        _, hs = lax.associative_scan(_linear_recurrence, (jnp.broadcast_to(a_bar, bu.shape), bu), axis=1)
        y = jnp.einsum('blgp,gcp->blgc', hs, c_mat).real if with_y else None
        return hs[:, -1], y

    h_last, ys = lax.scan(step, h0, jnp.moveaxis(uc, 1, 0))
    y = None if ys is None else jnp.moveaxis(ys, 0, 1).reshape(bsz, n, D_MODEL)
    return y, h_last


def _maybe_flip(t, rev):
    return jnp.flip(t, axis=1) if rev else t


def _s5_mix(h, hc, a_re, a_im, log_dt, b_re, b_im, c_re, c_im, d_skip, glu_w, glu_b, ctx_out):
    bsz = h.shape[0]
    d = d_skip.astype(jnp.float32)
    y = d * h.astype(jnp.float32)
    yc = d * hc.astype(jnp.float32) if ctx_out else None
    for direction in range(2):
        rev = direction == 1
        a_bar, b_bar, c_mat = _s5_discretise(a_re[direction], a_im[direction], log_dt[direction],
                                             b_re[direction], b_im[direction], c_re[direction], c_im[direction])
        h0 = jnp.zeros((bsz, SSM_GROUPS, SSM_STATE), jnp.complex64)
        yc_dir, h_ctx = _s5_scan(_maybe_flip(hc, rev), h0, a_bar, b_bar, c_mat, ctx_out)
        y_dir, _ = _s5_scan(_maybe_flip(h, rev), h_ctx, a_bar, b_bar, c_mat, True)
        y = y + _maybe_flip(y_dir, rev)
        if ctx_out:
            yc = yc + _maybe_flip(yc_dir, rev)

    def glu(t, like):
        z = jax.nn.gelu(t.astype(like.dtype))
        a, g = jnp.split(z @ glu_w + glu_b, 2, axis=-1)
        return a * jax.nn.sigmoid(g)

    return glu(y, h), (glu(yc, hc) if ctx_out else None)


def _moe(h, w_r, b_r, w1, b1, w2, b2):
    t, d = h.shape
    logits = h.astype(jnp.float32) @ w_r.astype(jnp.float32) + b_r.astype(jnp.float32)
    top_v, top_e = lax.top_k(logits, TOP_K)
    gates = jax.nn.softmax(top_v, axis=-1)
    n_assign = t * TOP_K
    flat_e = top_e.reshape(-1)
    flat_g = gates.reshape(-1)
    flat_tok = jnp.arange(n_assign, dtype=jnp.int32) // TOP_K
    order = jnp.argsort(flat_e)
    sorted_e = flat_e[order]
    counts = jnp.bincount(flat_e, length=N_EXPERTS)
    start = jnp.cumsum(counts) - counts
    padded = (counts + MOE_BLOCK - 1) // MOE_BLOCK * MOE_BLOCK
    pend = jnp.cumsum(padded)
    pstart = pend - padded
    dest = pstart[sorted_e] + jnp.arange(n_assign, dtype=jnp.int32) - start[sorted_e]
    n_rows = -(-n_assign // MOE_BLOCK) * MOE_BLOCK + N_EXPERTS * MOE_BLOCK
    n_blocks = n_rows // MOE_BLOCK
    row_tok = jnp.zeros((n_rows,), jnp.int32).at[dest].set(flat_tok[order])
    row_gate = jnp.zeros((n_rows,), jnp.float32).at[dest].set(flat_g[order])
    block_e = jnp.minimum(jnp.searchsorted(pend, jnp.arange(n_blocks, dtype=jnp.int32) * MOE_BLOCK, side='right'),
                          N_EXPERTS - 1)
    xb = h[row_tok].reshape(n_blocks, MOE_BLOCK, d)

    def expert_block(args):
        xe, e = args
        gate, lin = jnp.split(xe @ w1[e] + b1[e], 2, axis=-1)
        gate = jnp.minimum(gate, SWIGLU_LIMIT)
        lin = jnp.clip(lin, -SWIGLU_LIMIT, SWIGLU_LIMIT)
        return ((lin + 1) * gate * jax.nn.sigmoid(SWIGLU_ALPHA * gate)) @ w2[e] + b2[e]

    yb = lax.map(expert_block, (xb, block_e))
    y = jax.ops.segment_sum(yb.reshape(n_rows, d).astype(jnp.float32) * row_gate[:, None], row_tok,
                            num_segments=t)
    return y.astype(h.dtype)


def setup_inputs(seed: int = 0) -> dict:
    key = jax.random.key(seed)
    ks = iter(jax.random.split(key, 48))
    f = jnp.float32
    D = D_MODEL

    def nrm(shape, scale):
        return jax.random.normal(next(ks), shape, f) * scale

    n_a, n_b, n_c, n_d = (_mixer_layers(m) for m in (MIX_FOURIER, MIX_CONV, MIX_ATTN, MIX_SSM))
    x = nrm((BATCH, SEQ, D), 1.0)
    c = nrm((BATCH, D), 1.0)
    ctx = nrm((BATCH, CTX_LEN, D), 1.0)
    c_ctx = nrm((D,), 1.0)
    ada_w = nrm((DEPTH, D, 6 * D), 0.5 * D ** -0.5)
    ada_b = nrm((DEPTH, 6 * D), 0.01)
    norm1_g = 1.0 + nrm((DEPTH, D), 0.02)
    norm2_g = 1.0 + nrm((DEPTH, D), 0.02)
    fourier_w_out = nrm((n_a, D, D), D ** -0.5)
    fourier_b_out = nrm((n_a, D), 0.01)
    conv_w_in = nrm((n_b, D, 3 * D), D ** -0.5)
    conv_k = nrm((n_b, CONV_WIDTH, D), CONV_WIDTH ** -0.5)
    conv_b = nrm((n_b, D), 0.01)
    conv_w_out = nrm((n_b, D, D), D ** -0.5)
    attn_wq = nrm((n_c, D, N_HEADS * HEAD_DIM), D ** -0.5)
    attn_wk = nrm((n_c, D, N_KV_HEADS * HEAD_DIM), D ** -0.5)
    attn_wv = nrm((n_c, D, N_KV_HEADS * HEAD_DIM), D ** -0.5)
    attn_wo = nrm((n_c, N_HEADS * HEAD_DIM, D), (N_HEADS * HEAD_DIM) ** -0.5)
    attn_q_g = 1.0 + nrm((n_c, HEAD_DIM), 0.02)
    attn_k_g = 1.0 + nrm((n_c, HEAD_DIM), 0.02)
    ssm_shape = (n_d, 2, SSM_GROUPS, SSM_STATE)
    ssm_a_re = -0.5 + nrm(ssm_shape, 0.01)
    ssm_a_im = math.pi * jnp.arange(SSM_STATE, dtype=f) + nrm(ssm_shape, 0.01)
    ssm_log_dt = jax.random.uniform(next(ks), (n_d, 2, SSM_GROUPS), f, math.log(DT_MIN), math.log(DT_MAX))
    ssm_b_re = nrm((n_d, 2, SSM_GROUPS, SSM_STATE, SSM_GROUP_DIM), (2 * SSM_GROUP_DIM) ** -0.5)
    ssm_b_im = nrm((n_d, 2, SSM_GROUPS, SSM_STATE, SSM_GROUP_DIM), (2 * SSM_GROUP_DIM) ** -0.5)
    ssm_c_re = nrm((n_d, 2, SSM_GROUPS, SSM_GROUP_DIM, SSM_STATE), SSM_STATE ** -0.5)
    ssm_c_im = nrm((n_d, 2, SSM_GROUPS, SSM_GROUP_DIM, SSM_STATE), SSM_STATE ** -0.5)
    ssm_d = nrm((n_d, D), 1.0)
    ssm_glu_w = nrm((n_d, D, 2 * D), D ** -0.5)
    ssm_glu_b = nrm((n_d, 2 * D), 0.01)
    router_w = nrm((DEPTH, D, N_EXPERTS), D ** -0.5)
    router_b = nrm((DEPTH, N_EXPERTS), 0.01)
    moe_w1 = nrm((DEPTH, N_EXPERTS, D, 2 * D_EXPERT), D ** -0.5)
    moe_b1 = nrm((DEPTH, N_EXPERTS, 2 * D_EXPERT), 0.01)
    moe_w2 = nrm((DEPTH, N_EXPERTS, D_EXPERT, D), D_EXPERT ** -0.5)
    moe_b2 = nrm((DEPTH, N_EXPERTS, D), 0.01)
    return {'x': x, 'c': c, 'ctx': ctx, 'c_ctx': c_ctx, 'ada_w': ada_w, 'ada_b': ada_b,
            'norm1_g': norm1_g, 'norm2_g': norm2_g,
            'fourier_w_out': fourier_w_out, 'fourier_b_out': fourier_b_out,
            'conv_w_in': conv_w_in, 'conv_k': conv_k, 'conv_b': conv_b, 'conv_w_out': conv_w_out,
            'attn_wq': attn_wq, 'attn_wk': attn_wk, 'attn_wv': attn_wv, 'attn_wo': attn_wo,
            'attn_q_g': attn_q_g, 'attn_k_g': attn_k_g,
            'ssm_a_re': ssm_a_re, 'ssm_a_im': ssm_a_im, 'ssm_log_dt': ssm_log_dt,
            'ssm_b_re': ssm_b_re, 'ssm_b_im': ssm_b_im, 'ssm_c_re': ssm_c_re, 'ssm_c_im': ssm_c_im,
            'ssm_d': ssm_d, 'ssm_glu_w': ssm_glu_w, 'ssm_glu_b': ssm_glu_b,
            'router_w': router_w, 'router_b': router_b,
            'moe_w1': moe_w1, 'moe_b1': moe_b1, 'moe_w2': moe_w2, 'moe_b2': moe_b2}


def reference(x, c, ctx, c_ctx, ada_w, ada_b, norm1_g, norm2_g, fourier_w_out, fourier_b_out,
              conv_w_in, conv_k, conv_b, conv_w_out, attn_wq, attn_wk, attn_wv, attn_wo, attn_q_g, attn_k_g,
              ssm_a_re, ssm_a_im, ssm_log_dt, ssm_b_re, ssm_b_im, ssm_c_re, ssm_c_im, ssm_d, ssm_glu_w, ssm_glu_b,
              router_w, router_b, moe_w1, moe_b1, moe_w2, moe_b2):
    d = x.shape[-1]
    x_ctx = ctx
    for i in range(DEPTH):
        m, j = i % N_MIXERS, i // N_MIXERS
        last = i == DEPTH - 1
        ctx_out = not last
        sh1, sc1, g1, sh2, sc2, g2 = [t[:, None, :] for t in _split_mod(c, ada_w[i], ada_b[i])]
        csh1, csc1, cg1, csh2, csc2, cg2 = _split_mod(c_ctx, ada_w[i], ada_b[i])
        h = _modulate(x, norm1_g[i], sh1, sc1)
        needs_ctx_in = ctx_out or m in (MIX_ATTN, MIX_SSM)
        hc = _modulate(x_ctx, norm1_g[i], csh1, csc1) if needs_ctx_in else None
        if m == MIX_FOURIER:
            y, yc = _fourier_mix(h, hc, fourier_w_out[j], fourier_b_out[j])
        elif m == MIX_CONV:
            y, yc = _short_conv_mix(h, hc, conv_w_in[j], conv_k[j], conv_b[j], conv_w_out[j])
        elif m == MIX_ATTN:
            y, yc = _gqa_mix(h, hc, attn_wq[j], attn_wk[j], attn_wv[j], attn_wo[j], attn_q_g[j], attn_k_g[j],
                             ctx_out)
        else:
            y, yc = _s5_mix(h, hc, ssm_a_re[j], ssm_a_im[j], ssm_log_dt[j], ssm_b_re[j], ssm_b_im[j],
                            ssm_c_re[j], ssm_c_im[j], ssm_d[j], ssm_glu_w[j], ssm_glu_b[j], ctx_out)
        x = x + g1 * y
        h2 = _modulate(x, norm2_g[i], sh2, sc2)
        moe_args = (router_w[i], router_b[i], moe_w1[i], moe_b1[i], moe_w2[i], moe_b2[i])
        if last:
            x = x + g2 * _moe(h2.reshape(-1, d), *moe_args).reshape(h2.shape)
        else:
            x_ctx = x_ctx + cg1 * yc
            hc2 = _modulate(x_ctx, norm2_g[i], csh2, csc2)
            n_lat = h2.shape[0] * h2.shape[1]
            out = _moe(jnp.concatenate([h2.reshape(-1, d), hc2.reshape(-1, d)], axis=0), *moe_args)
            x = x + g2 * out[:n_lat].reshape(h2.shape)
            x_ctx = x_ctx + cg2 * out[n_lat:].reshape(hc2.shape)
    return x
```

```cpp
#include <hip/hip_runtime.h>
#include <hip/hip_bf16.h>
#include <cstdio>
#include <cstdint>
namespace att {
using bf16 = __hip_bfloat16;
constexpr int   D = 128, NW = 8, QBLK = 32, KVBLK = 64;
constexpr float SCALE = 0.088388347648318440f;
constexpr float THR = 8.f;
constexpr int SDEPTH = 2;
constexpr int LDQ = 2048, LDK = 512, LDO = 2048;
constexpr size_t SHM_V = KVBLK * D * 2, SHM_K = KVBLK * D * 2, SHM_ATTN = 2 * SHM_V + 2 * SHM_K + NW * 64 * 4;
using bf16x8 = __attribute__((ext_vector_type(8))) short;
using s16x4  = __attribute__((ext_vector_type(4))) short;
using f32x16 = __attribute__((ext_vector_type(16))) float;
using f32x8  = __attribute__((ext_vector_type(8))) float;
using u32x4  = __attribute__((ext_vector_type(4))) unsigned;
#define KSWZ(row, colB) ((row) * 256 + ((colB) ^ (((row) & 7) << 4)))
#define SBAR() __builtin_amdgcn_sched_barrier(0)
__device__ __forceinline__ int crow(int r, int hi) { return (r & 3) + 8 * (r >> 2) + 4 * hi; }
__device__ __forceinline__ unsigned cvtpk(float lo, float hi) {
  unsigned r; asm volatile("v_cvt_pk_bf16_f32 %0, %1, %2" : "=v"(r) : "v"(lo), "v"(hi)); return r;
}
template <typename TIn> struct Stage;
template <> struct Stage<bf16>  { using T = bf16x8;
  __device__ static __forceinline__ T ld8(const bf16* p) { return *reinterpret_cast<const bf16x8*>(p); }
  __device__ static __forceinline__ bf16x8 tobf(T x) { return x; } };
template <> struct Stage<float> { using T = f32x8;
  __device__ static __forceinline__ T ld8(const float* p) { return *reinterpret_cast<const f32x8*>(p); }
  __device__ static __forceinline__ bf16x8 tobf(T x) {
    u32x4 w = {cvtpk(x[0], x[1]), cvtpk(x[2], x[3]), cvtpk(x[4], x[5]), cvtpk(x[6], x[7])}; return *reinterpret_cast<bf16x8*>(&w); } };

__device__ __forceinline__ void partialSM(f32x16& p0, f32x16& p1, float& m_reg, float& mn, float& alpha) {
  constexpr float C = SCALE * 1.4426950408889634f;
  float pmax = p0[0]; for (int r = 1; r < 16; ++r) pmax = fmaxf(pmax, p0[r]); for (int r = 0; r < 16; ++r) pmax = fmaxf(pmax, p1[r]);
  { auto rr = __builtin_amdgcn_permlane32_swap(__float_as_uint(pmax), __float_as_uint(pmax), false, false);
    pmax = fmaxf(__uint_as_float(rr[0]), __uint_as_float(rr[1])); }
  if (__builtin_expect(__all(pmax - m_reg <= THR / SCALE), 1)) { mn = m_reg; alpha = 1.f; }
  else { mn = fmaxf(m_reg, pmax); alpha = __builtin_amdgcn_exp2f((m_reg - mn) * C); m_reg = mn; }
  float mnC = -mn * C;
  for (int r = 0; r < 16; ++r) p0[r] = fmaf(p0[r], C, mnC); for (int r = 0; r < 16; ++r) p1[r] = fmaf(p1[r], C, mnC);
  for (int r = 0; r < 16; ++r) p0[r] = __builtin_amdgcn_exp2f(p0[r]);
}
__device__ __forceinline__ void finishSM(f32x16& p0, f32x16& p1, float alpha, float& l_reg, bf16x8& pa0, bf16x8& pa1, bf16x8& pa2, bf16x8& pa3) {
  for (int r = 0; r < 16; ++r) p1[r] = __builtin_amdgcn_exp2f(p1[r]);
  float ps = 0; for (int r = 0; r < 16; ++r) ps += p0[r]; for (int r = 0; r < 16; ++r) ps += p1[r];
  { auto rr = __builtin_amdgcn_permlane32_swap(__float_as_uint(ps), __float_as_uint(ps), false, false);
    ps = __uint_as_float(rr[0]) + __uint_as_float(rr[1]); }
  l_reg = l_reg * alpha + ps;
#define PK4(P, BASE, OUT) do { unsigned a0 = cvtpk(P[BASE + 0], P[BASE + 1]), a1 = cvtpk(P[BASE + 2], P[BASE + 3]);   \
    unsigned b0 = cvtpk(P[BASE + 4], P[BASE + 5]), b1 = cvtpk(P[BASE + 6], P[BASE + 7]);                              \
    auto r0 = __builtin_amdgcn_permlane32_swap(a0, b0, false, false); auto r1 = __builtin_amdgcn_permlane32_swap(a1, b1, false, false); \
    u32x4 w = {r0[0], r1[0], r0[1], r1[1]}; OUT = *reinterpret_cast<bf16x8*>(&w); } while (0)
  PK4(p0, 0, pa0); PK4(p0, 8, pa1); PK4(p1, 0, pa2); PK4(p1, 8, pa3);
#undef PK4
}
__device__ __forceinline__ void qkt(f32x16& p0, f32x16& p1, const bf16* Ks, const bf16x8* qr, int r32, int hi) {
  p0 = f32x16{}; p1 = f32x16{};
  for (int d0 = 0; d0 < 8; ++d0) { int cb = (d0 * 16 + hi * 8) * 2;
    bf16x8 b0 = *reinterpret_cast<const bf16x8*>((const char*)Ks + KSWZ(r32, cb));
    bf16x8 b1 = *reinterpret_cast<const bf16x8*>((const char*)Ks + KSWZ(32 + r32, cb));
    p0 = __builtin_amdgcn_mfma_f32_32x32x16_bf16(b0, qr[d0], p0, 0, 0, 0);
    p1 = __builtin_amdgcn_mfma_f32_32x32x16_bf16(b1, qr[d0], p1, 0, 0, 0); }
}
__device__ __forceinline__ int v_st(int k, int c) { const int kk = (k & ~0xC) | ((k & 4) << 1) | ((k & 8) >> 1); return ((kk >> 3) * 4 + (c >> 5)) * 512 + ((kk & 7) * 32 + (c & 31)) * 2; }
__device__ __forceinline__ int v_rd_base(int lane) { return ((lane & 3) << 3) | (((lane >> 2) & 3) << 6) | (((lane >> 4) & 1) << 5) | (((lane >> 5) & 1) << 8); }
constexpr int v_rd_off(int d0, int ks, int half) { return d0 * 512 + ks * 4096 + half * 2048; }
template <int OFF> __device__ __forceinline__ s16x4 tr_read(int vb) {
  s16x4 r; asm volatile("ds_read_b64_tr_b16 %0, %1 offset:%2" : "=&v"(r) : "v"(vb), "i"(OFF) : "memory"); return r;
}
template <int D0> __device__ __forceinline__ void pv_one(f32x16& od, int vb, bf16x8 pa0, bf16x8 pa1, bf16x8 pa2, bf16x8 pa3) {
  const s16x4 l0 = tr_read<v_rd_off(D0, 0, 0)>(vb), h0 = tr_read<v_rd_off(D0, 0, 1)>(vb), l1 = tr_read<v_rd_off(D0, 1, 0)>(vb), h1 = tr_read<v_rd_off(D0, 1, 1)>(vb);
  const s16x4 l2 = tr_read<v_rd_off(D0, 2, 0)>(vb), h2 = tr_read<v_rd_off(D0, 2, 1)>(vb), l3 = tr_read<v_rd_off(D0, 3, 0)>(vb), h3 = tr_read<v_rd_off(D0, 3, 1)>(vb);
  asm volatile("s_waitcnt lgkmcnt(0)" ::: "memory"); SBAR();
#define PK(L, H) (bf16x8){L[0], L[1], L[2], L[3], H[0], H[1], H[2], H[3]}
  od = __builtin_amdgcn_mfma_f32_32x32x16_bf16(pa0, PK(l0, h0), od, 0, 0, 0);
  od = __builtin_amdgcn_mfma_f32_32x32x16_bf16(pa1, PK(l1, h1), od, 0, 0, 0);
  od = __builtin_amdgcn_mfma_f32_32x32x16_bf16(pa2, PK(l2, h2), od, 0, 0, 0);
  od = __builtin_amdgcn_mfma_f32_32x32x16_bf16(pa3, PK(l3, h3), od, 0, 0, 0);
#undef PK
}
__device__ __forceinline__ void pv_d0(f32x16* o, int vb, bf16x8 pa0, bf16x8 pa1, bf16x8 pa2, bf16x8 pa3) {
  pv_one<0>(o[0], vb, pa0, pa1, pa2, pa3); pv_one<1>(o[1], vb, pa0, pa1, pa2, pa3); pv_one<2>(o[2], vb, pa0, pa1, pa2, pa3); pv_one<3>(o[3], vb, pa0, pa1, pa2, pa3);
}

__device__ __forceinline__ void st_out(float* p, float v) { *p = v; }
__device__ __forceinline__ void st_out(bf16* p, float v) { *p = __float2bfloat16(v); }
template <typename TQ, typename TO>
__device__ __forceinline__ void attn_dense_body(const TQ* __restrict__ Qb, const bf16* __restrict__ Kh, const bf16* __restrict__ Vh,
                                                TO* __restrict__ Ob, int seq, char* lds) {
  using St = Stage<bf16>; using SQ = Stage<TQ>;
  const int tid = threadIdx.x, wid = tid >> 6, lane = tid & 63, r32 = lane & 31, hi = lane >> 5;
  bf16* V_lds = (bf16*)lds; bf16* K_lds = (bf16*)(lds + 2 * SHM_V);
  float* ws = (float*)(lds + 2 * SHM_V + 2 * SHM_K) + wid * 64; float* li_l = ws; float* al_l = ws + 32;
  float m_reg = -1e30f, l_reg = 0; f32x16 o[4] = {}; bf16x8 qr[8];
  const TQ* Qw = Qb + (long)(wid * QBLK + r32) * LDQ + hi * 8;
#pragma unroll
  for (int d0 = 0; d0 < 8; ++d0) qr[d0] = SQ::tobf(SQ::ld8(Qw + d0 * 16));
  const int sr = tid >> 4, sc = (tid & 15) * 8, vst0 = v_st(sr, sc), vst1 = v_st(32 + sr, sc);
  const int vb0 = (int)(uintptr_t)V_lds + v_rd_base(lane);
  struct { typename St::T vs0, vs1, ks0, ks1; } sr_[SDEPTH];
#define SLOAD(i, k0) do { sr_[i].vs0 = St::ld8(&Vh[(long)((k0) + sr) * LDK + sc]); sr_[i].vs1 = St::ld8(&Vh[(long)((k0) + 32 + sr) * LDK + sc]); \
    sr_[i].ks0 = St::ld8(&Kh[(long)((k0) + sr) * LDK + sc]); sr_[i].ks1 = St::ld8(&Kh[(long)((k0) + 32 + sr) * LDK + sc]); } while (0)
#define SWRITE(b, i) do { *(bf16x8*)((char*)V_lds + (b) * SHM_V + vst0) = St::tobf(sr_[i].vs0);          \
    *(bf16x8*)((char*)V_lds + (b) * SHM_V + vst1) = St::tobf(sr_[i].vs1); int kc = sc * 2;               \
    *(bf16x8*)((char*)K_lds + (b) * SHM_K + KSWZ(sr, kc)) = St::tobf(sr_[i].ks0);                       \
    *(bf16x8*)((char*)K_lds + (b) * SHM_K + KSWZ(32 + sr, kc)) = St::tobf(sr_[i].ks1); } while (0)
#define SWAIT() do { if constexpr (SDEPTH == 2) asm volatile("s_waitcnt vmcnt(4)" ::: "memory"); else asm volatile("s_waitcnt vmcnt(0)" ::: "memory"); } while (0)
#define RESC(a) do { if (__any((a) < 1.f)) { if (hi == 0) al_l[r32] = (a); asm volatile("s_waitcnt lgkmcnt(0)" ::: "memory"); \
    for (int d = 0; d < 4; ++d) for (int r = 0; r < 16; ++r) o[d][r] *= al_l[crow(r, hi)]; } } while (0)
  f32x16 pA0, pA1, pB0, pB1; float mnA, mnB, alA, alB; bf16x8 pa0, pa1, pa2, pa3; const int NT = seq / KVBLK;
  constexpr int SE = 0, SO = SDEPTH - 1;
  SLOAD(SE, 0); asm volatile("s_waitcnt vmcnt(0)" ::: "memory"); SWRITE(0, SE); __syncthreads();
  qkt(pA0, pA1, K_lds, qr, r32, hi); partialSM(pA0, pA1, m_reg, mnA, alA);
  SLOAD(SO, KVBLK); if constexpr (SDEPTH == 2) { if (2 < NT) SLOAD(SE, 2 * KVBLK); }
  SWAIT(); SWRITE(1, SO); __syncthreads();
  for (int j = 1; j + 1 < NT; j += 2) {
    SBAR(); qkt(pB0, pB1, (bf16*)((char*)K_lds + SHM_K), qr, r32, hi);
    finishSM(pA0, pA1, alA, l_reg, pa0, pa1, pa2, pa3); SBAR();
    SLOAD(SO, (j + SDEPTH) * KVBLK); SBAR();
    pv_d0(o, vb0, pa0, pa1, pa2, pa3); partialSM(pB0, pB1, m_reg, mnB, alB);
    __syncthreads(); SWAIT(); SWRITE(0, SE);
    RESC(alB); __syncthreads();
    SBAR(); qkt(pA0, pA1, K_lds, qr, r32, hi);
    finishSM(pB0, pB1, alB, l_reg, pa0, pa1, pa2, pa3); SBAR();
    if (SDEPTH == 1 || j + 3 < NT) SLOAD(SE, (j + 1 + SDEPTH) * KVBLK); SBAR();
    pv_d0(o, vb0 + (int)SHM_V, pa0, pa1, pa2, pa3); partialSM(pA0, pA1, m_reg, mnA, alA);
    __syncthreads(); SWAIT(); SWRITE(1, SO);
    RESC(alA); __syncthreads();
  }
  SBAR(); qkt(pB0, pB1, (bf16*)((char*)K_lds + SHM_K), qr, r32, hi);
  finishSM(pA0, pA1, alA, l_reg, pa0, pa1, pa2, pa3); SBAR();
  pv_d0(o, vb0, pa0, pa1, pa2, pa3); partialSM(pB0, pB1, m_reg, mnB, alB);
  __syncthreads(); RESC(alB);
  finishSM(pB0, pB1, alB, l_reg, pa0, pa1, pa2, pa3); SBAR();
  pv_d0(o, vb0 + (int)SHM_V, pa0, pa1, pa2, pa3);
  if (hi == 0) li_l[r32] = l_reg; asm volatile("s_waitcnt lgkmcnt(0)" ::: "memory");
  float rli[16];
#pragma unroll
  for (int r = 0; r < 16; ++r) rli[r] = __builtin_amdgcn_rcpf(li_l[crow(r, hi)]);
  TO* Ow = Ob + (long)(wid * QBLK) * LDO;
#pragma unroll
  for (int r = 0; r < 16; ++r) { int orow = crow(r, hi);
    for (int d0 = 0; d0 < 4; ++d0) st_out(&Ow[(long)orow * LDO + d0 * 32 + r32], o[d0][r] * rli[r]); }
#undef SLOAD
#undef SWRITE
#undef SWAIT
#undef RESC
}

using i32x8 = __attribute__((ext_vector_type(8))) int;
constexpr int LDQ8 = 2048, LDK8 = 512;
constexpr size_t SHM_K8 = KVBLK * D;
#define KSWZ8(row, colB) ((row) * 128 + ((colB) ^ (((row) & 7) << 4)))
__device__ __forceinline__ i32x8 cat8(u32x4 a, u32x4 b) { const __attribute__((ext_vector_type(8))) unsigned w = __builtin_shufflevector(a, b, 0, 1, 2, 3, 4, 5, 6, 7); return __builtin_bit_cast(i32x8, w); }
__device__ __forceinline__ void qkt8(f32x16& p0, f32x16& p1, const char* Ks, const i32x8* qr, int r32, int hi) {
  p0 = f32x16{}; p1 = f32x16{};
#pragma unroll
  for (int t = 0; t < 2; ++t) { const int cb = 64 * t + 32 * hi;
    const u32x4 a0 = *reinterpret_cast<const u32x4*>(Ks + KSWZ8(r32, cb)), a1 = *reinterpret_cast<const u32x4*>(Ks + KSWZ8(r32, cb + 16));
    const u32x4 b0 = *reinterpret_cast<const u32x4*>(Ks + KSWZ8(32 + r32, cb)), b1 = *reinterpret_cast<const u32x4*>(Ks + KSWZ8(32 + r32, cb + 16));
    p0 = __builtin_amdgcn_mfma_scale_f32_32x32x64_f8f6f4(cat8(a0, a1), qr[t], p0, 0, 0, 0, 0, 0, 0);
    p1 = __builtin_amdgcn_mfma_scale_f32_32x32x64_f8f6f4(cat8(b0, b1), qr[t], p1, 0, 0, 0, 0, 0, 0); }
}
template <typename TO>
__device__ __forceinline__ void attn_dense_body_f8(const unsigned char* __restrict__ Qb, const unsigned char* __restrict__ Kh, const bf16* __restrict__ Vh,
                                                   TO* __restrict__ Ob, int seq, char* lds) {
  using St = Stage<bf16>;
  const int tid = threadIdx.x, wid = tid >> 6, lane = tid & 63, r32 = lane & 31, hi = lane >> 5;
  bf16* V_lds = (bf16*)lds; bf16* K_lds = (bf16*)(lds + 2 * SHM_V);
  float* ws = (float*)(lds + 2 * SHM_V + 2 * SHM_K) + wid * 64; float* li_l = ws; float* al_l = ws + 32;
  float m_reg = -1e30f, l_reg = 0; f32x16 o[4] = {}; i32x8 qr[2];
  const unsigned char* Qw = Qb + (long)(wid * QBLK + r32) * LDQ8 + hi * 32;
#pragma unroll
  for (int t = 0; t < 2; ++t) { const u32x4 lo = *reinterpret_cast<const u32x4*>(Qw + 64 * t), up = *reinterpret_cast<const u32x4*>(Qw + 64 * t + 16); qr[t] = cat8(lo, up); }
  const int krow = tid >> 3, kch = (tid & 7) * 16, kst = KSWZ8(krow, kch);
  const int sr = tid >> 4, sc = (tid & 15) * 8, vst0 = v_st(sr, sc), vst1 = v_st(32 + sr, sc);
  const int vb0 = (int)(uintptr_t)V_lds + v_rd_base(lane);
  struct { typename St::T vs0, vs1; u32x4 ks; } sr_[SDEPTH];
#define SLOAD(i, k0) do { sr_[i].vs0 = St::ld8(&Vh[(long)((k0) + sr) * LDK + sc]); sr_[i].vs1 = St::ld8(&Vh[(long)((k0) + 32 + sr) * LDK + sc]); \
    sr_[i].ks = *reinterpret_cast<const u32x4*>(Kh + (long)((k0) + krow) * LDK8 + kch); } while (0)
#define SWRITE(b, i) do { *(bf16x8*)((char*)V_lds + (b) * SHM_V + vst0) = St::tobf(sr_[i].vs0);          \
    *(bf16x8*)((char*)V_lds + (b) * SHM_V + vst1) = St::tobf(sr_[i].vs1);                                \
    *(u32x4*)((char*)K_lds + (b) * SHM_K8 + kst) = sr_[i].ks; } while (0)
#define SWAIT() do { if constexpr (SDEPTH == 2) asm volatile("s_waitcnt vmcnt(3)" ::: "memory"); else asm volatile("s_waitcnt vmcnt(0)" ::: "memory"); } while (0)
#define RESC(a) do { if (__any((a) < 1.f)) { if (hi == 0) al_l[r32] = (a); asm volatile("s_waitcnt lgkmcnt(0)" ::: "memory"); \
    for (int d = 0; d < 4; ++d) for (int r = 0; r < 16; ++r) o[d][r] *= al_l[crow(r, hi)]; } } while (0)
  f32x16 pA0, pA1, pB0, pB1; float mnA, mnB, alA, alB; bf16x8 pa0, pa1, pa2, pa3; const int NT = seq / KVBLK;
  constexpr int SE = 0, SO = SDEPTH - 1;
  SLOAD(SE, 0); asm volatile("s_waitcnt vmcnt(0)" ::: "memory"); SWRITE(0, SE); __syncthreads();
  qkt8(pA0, pA1, (const char*)K_lds, qr, r32, hi); partialSM(pA0, pA1, m_reg, mnA, alA);
  SLOAD(SO, KVBLK); if constexpr (SDEPTH == 2) { if (2 < NT) SLOAD(SE, 2 * KVBLK); }
  SWAIT(); SWRITE(1, SO); __syncthreads();
  for (int j = 1; j + 1 < NT; j += 2) {
    SBAR(); qkt8(pB0, pB1, (const char*)K_lds + SHM_K8, qr, r32, hi);
    finishSM(pA0, pA1, alA, l_reg, pa0, pa1, pa2, pa3); SBAR();
    SLOAD(SO, (j + SDEPTH) * KVBLK); SBAR();
    pv_d0(o, vb0, pa0, pa1, pa2, pa3); partialSM(pB0, pB1, m_reg, mnB, alB);
    __syncthreads(); SWAIT(); SWRITE(0, SE);
    RESC(alB); __syncthreads();
    SBAR(); qkt8(pA0, pA1, (const char*)K_lds, qr, r32, hi);
    finishSM(pB0, pB1, alB, l_reg, pa0, pa1, pa2, pa3); SBAR();
    if (SDEPTH == 1 || j + 3 < NT) SLOAD(SE, (j + 1 + SDEPTH) * KVBLK); SBAR();
    pv_d0(o, vb0 + (int)SHM_V, pa0, pa1, pa2, pa3); partialSM(pA0, pA1, m_reg, mnA, alA);
    __syncthreads(); SWAIT(); SWRITE(1, SO);
    RESC(alA); __syncthreads();
  }
  SBAR(); qkt8(pB0, pB1, (const char*)K_lds + SHM_K8, qr, r32, hi);
  finishSM(pA0, pA1, alA, l_reg, pa0, pa1, pa2, pa3); SBAR();
  pv_d0(o, vb0, pa0, pa1, pa2, pa3); partialSM(pB0, pB1, m_reg, mnB, alB);
  __syncthreads(); RESC(alB);
  finishSM(pB0, pB1, alB, l_reg, pa0, pa1, pa2, pa3); SBAR();
  pv_d0(o, vb0 + (int)SHM_V, pa0, pa1, pa2, pa3);
  if (hi == 0) li_l[r32] = l_reg; asm volatile("s_waitcnt lgkmcnt(0)" ::: "memory");
  float rli[16];
#pragma unroll
  for (int r = 0; r < 16; ++r) rli[r] = __builtin_amdgcn_rcpf(li_l[crow(r, hi)]);
  TO* Ow = Ob + (long)(wid * QBLK) * LDO;
#pragma unroll
  for (int r = 0; r < 16; ++r) { int orow = crow(r, hi);
    for (int d0 = 0; d0 < 4; ++d0) st_out(&Ow[(long)orow * LDO + d0 * 32 + r32], o[d0][r] * rli[r]); }
#undef SLOAD
#undef SWRITE
#undef SWAIT
#undef RESC
}


constexpr float THR8 = 0.5f;
constexpr size_t SHM_V8 = KVBLK * D;
#define VSWZ8(row, ch) ((row) * 64 + (((ch) ^ (((row) >> 2) & 3)) << 4))
__device__ __forceinline__ void partialSM8(f32x16& p0, f32x16& p1, float& m_reg, float& mn, float& alpha) {
  constexpr float C = SCALE * 1.4426950408889634f;
  float pmax = p0[0]; for (int r = 1; r < 16; ++r) pmax = fmaxf(pmax, p0[r]); for (int r = 0; r < 16; ++r) pmax = fmaxf(pmax, p1[r]);
  { auto rr = __builtin_amdgcn_permlane32_swap(__float_as_uint(pmax), __float_as_uint(pmax), false, false);
    pmax = fmaxf(__uint_as_float(rr[0]), __uint_as_float(rr[1])); }
  if (__builtin_expect(__all(pmax - m_reg <= THR8 / SCALE), 1)) { mn = m_reg; alpha = 1.f; }
  else { mn = fmaxf(m_reg, pmax); alpha = __builtin_amdgcn_exp2f((m_reg - mn) * C); m_reg = mn; }
  float mnC = -mn * C + 8.f;
  for (int r = 0; r < 16; ++r) p0[r] = fmaf(p0[r], C, mnC); for (int r = 0; r < 16; ++r) p1[r] = fmaf(p1[r], C, mnC);
  for (int r = 0; r < 16; ++r) p0[r] = __builtin_amdgcn_exp2f(p0[r]);
}
__device__ __forceinline__ void finishSM8(f32x16& p0, f32x16& p1, float alpha, float& l_reg, i32x8& pa) {
  for (int r = 0; r < 16; ++r) p1[r] = __builtin_amdgcn_exp2f(p1[r]);
  float ps = 0; for (int r = 0; r < 16; ++r) ps += p0[r]; for (int r = 0; r < 16; ++r) ps += p1[r];
  { auto rr = __builtin_amdgcn_permlane32_swap(__float_as_uint(ps), __float_as_uint(ps), false, false);
    ps = __uint_as_float(rr[0]) + __uint_as_float(rr[1]); }
  l_reg = l_reg * alpha + ps;
#pragma unroll
  for (int w = 0; w < 4; ++w) { int x = __builtin_amdgcn_cvt_pk_fp8_f32(p0[4 * w], p0[4 * w + 1], pa[w], false); x = __builtin_amdgcn_cvt_pk_fp8_f32(p0[4 * w + 2], p0[4 * w + 3], x, true); pa[w] = x;
    int y = __builtin_amdgcn_cvt_pk_fp8_f32(p1[4 * w], p1[4 * w + 1], pa[4 + w], false); y = __builtin_amdgcn_cvt_pk_fp8_f32(p1[4 * w + 2], p1[4 * w + 3], y, true); pa[4 + w] = y; }
}
__device__ __forceinline__ void pv8(f32x16* o, const char* Vs, int r32, int hi, i32x8 pa) {
#pragma unroll
  for (int d0 = 0; d0 < 4; ++d0) { const int row = d0 * 32 + r32;
    const u32x4 lo = *reinterpret_cast<const u32x4*>(Vs + VSWZ8(row, 2 * hi)), up = *reinterpret_cast<const u32x4*>(Vs + VSWZ8(row, 2 * hi + 1));
    o[d0] = __builtin_amdgcn_mfma_scale_f32_32x32x64_f8f6f4(pa, cat8(lo, up), o[d0], 0, 0, 0, 0, 0, 0); }
}
constexpr float QK_FOLD = 0.35706690f;
constexpr float TARG8 = 8.f + THR8 * 1.4426950408889634f;
__device__ __forceinline__ void qkt8b(f32x16& p0, f32x16& p1, const char* Ks, const i32x8* qr, int r32, int hi, const f32x16& cb) {
  { const int cb0 = 32 * hi;
    const u32x4 a0 = *reinterpret_cast<const u32x4*>(Ks + KSWZ8(r32, cb0)), a1 = *reinterpret_cast<const u32x4*>(Ks + KSWZ8(r32, cb0 + 16));
    const u32x4 b0 = *reinterpret_cast<const u32x4*>(Ks + KSWZ8(32 + r32, cb0)), b1 = *reinterpret_cast<const u32x4*>(Ks + KSWZ8(32 + r32, cb0 + 16));
    p0 = __builtin_amdgcn_mfma_scale_f32_32x32x64_f8f6f4(cat8(a0, a1), qr[0], cb, 0, 0, 0, 0, 0, 0);
    p1 = __builtin_amdgcn_mfma_scale_f32_32x32x64_f8f6f4(cat8(b0, b1), qr[0], cb, 0, 0, 0, 0, 0, 0); }
  { const int cb1 = 64 + 32 * hi;
    const u32x4 a0 = *reinterpret_cast<const u32x4*>(Ks + KSWZ8(r32, cb1)), a1 = *reinterpret_cast<const u32x4*>(Ks + KSWZ8(r32, cb1 + 16));
    const u32x4 b0 = *reinterpret_cast<const u32x4*>(Ks + KSWZ8(32 + r32, cb1)), b1 = *reinterpret_cast<const u32x4*>(Ks + KSWZ8(32 + r32, cb1 + 16));
    p0 = __builtin_amdgcn_mfma_scale_f32_32x32x64_f8f6f4(cat8(a0, a1), qr[1], p0, 0, 0, 0, 0, 0, 0);
    p1 = __builtin_amdgcn_mfma_scale_f32_32x32x64_f8f6f4(cat8(b0, b1), qr[1], p1, 0, 0, 0, 0, 0, 0); }
}
template <bool FIRST>
__device__ __forceinline__ void partialSM8b(f32x16& p0, f32x16& p1, f32x16& cb, float& alpha) {
  float pmax = p0[0]; for (int r = 1; r < 16; ++r) pmax = fmaxf(pmax, p0[r]); for (int r = 0; r < 16; ++r) pmax = fmaxf(pmax, p1[r]);
  { auto rr = __builtin_amdgcn_permlane32_swap(__float_as_uint(pmax), __float_as_uint(pmax), false, false);
    pmax = fmaxf(__uint_as_float(rr[0]), __uint_as_float(rr[1])); }
  if (!FIRST && __builtin_expect(__all(pmax <= TARG8), 1)) { alpha = 1.f; }
  else { const float delta = FIRST ? (pmax - 8.f) : fmaxf(pmax - 8.f, 0.f);
    alpha = FIRST ? 1.f : __builtin_amdgcn_exp2f(-delta);
    for (int r = 0; r < 16; ++r) { p0[r] -= delta; p1[r] -= delta; cb[r] -= delta; } }
  for (int r = 0; r < 16; ++r) p0[r] = __builtin_amdgcn_exp2f(p0[r]);
}
template <typename TO>
__device__ __forceinline__ void attn_dense_body_f8pv(const unsigned char* __restrict__ Qb, const unsigned char* __restrict__ Kh, const unsigned char* __restrict__ Vt,
                                                     TO* __restrict__ Ob, int seq, char* lds) {
  const int tid = threadIdx.x, wid = __builtin_amdgcn_readfirstlane(tid >> 6), lane = tid & 63, r32 = lane & 31, hi = lane >> 5;
  char* V_lds = lds; char* K_lds = lds + 4 * SHM_V8;
  float* ws = (float*)(lds + 4 * SHM_V8 + 4 * SHM_K8) + wid * 64; float* li_l = ws; float* al_l = ws + 32;
  float l_reg = 0; f32x16 o[4] = {}; i32x8 qr[2]; f32x16 cb; for (int r = 0; r < 16; ++r) cb[r] = 8.f;
  const unsigned char* Qw = Qb + (long)(wid * QBLK + r32) * LDQ8 + hi * 32;
#pragma unroll
  for (int t = 0; t < 2; ++t) { const u32x4 lo = *reinterpret_cast<const u32x4*>(Qw + 64 * t), up = *reinterpret_cast<const u32x4*>(Qw + 64 * t + 16); qr[t] = cat8(lo, up); }
  const int krow = tid >> 3, vrow = tid >> 2;
  const unsigned char* kp = Kh + (long)krow * LDK8 + (((tid & 7) ^ (krow & 7)) << 4);
  const unsigned char* vp = Vt + vrow * 64 + (((tid & 3) ^ ((vrow >> 2) & 3)) << 4);
#define GLDS16(g, l) __builtin_amdgcn_global_load_lds((const unsigned*)(g), (__attribute__((address_space(3))) unsigned*)(l), 16, 0, 0)
#define DMA(tile, slot) do { GLDS16(kp + (long)(tile) * (KVBLK * LDK8), K_lds + (slot) * SHM_K8 + wid * 1024); GLDS16(vp + (long)(tile) * SHM_V8, V_lds + (slot) * SHM_V8 + wid * 1024); } while (0)
#define WAITV(n) asm volatile("s_waitcnt vmcnt(" #n ")" ::: "memory")
#define BAR() do { __builtin_amdgcn_s_barrier(); asm volatile("" ::: "memory"); } while (0)
#define RESC(a) do { if (__any((a) < 1.f)) { if (hi == 0) al_l[r32] = (a); asm volatile("s_waitcnt lgkmcnt(0)" ::: "memory"); \
    for (int d = 0; d < 4; ++d) for (int r = 0; r < 16; ++r) o[d][r] *= al_l[crow(r, hi)]; } } while (0)
  f32x16 pA0, pA1, pB0, pB1; float alA, alB; i32x8 pa = {}; const int NT = seq / KVBLK;
  DMA(0, 0); DMA(1, 1);
  WAITV(2); BAR();
  DMA(2, 2);
  qkt8b(pA0, pA1, K_lds, qr, r32, hi, cb); partialSM8b<true>(pA0, pA1, cb, alA);
  WAITV(2); BAR();
#define STEP(jj, PC0, PC1, alC, PP0, PP1, alP, slotK, slotVp, slotD) \
  if ((jj) < NT) { const bool more = (jj) + 2 < NT; if (more) DMA((jj) + 2, slotD); \
    SBAR(); qkt8b(PC0, PC1, K_lds + (slotK) * SHM_K8, qr, r32, hi, cb); \
    finishSM8(PP0, PP1, alP, l_reg, pa); SBAR(); \
    pv8(o, V_lds + (slotVp) * SHM_V8, r32, hi, pa); partialSM8b<false>(PC0, PC1, cb, alC); \
    if (more) WAITV(2); else WAITV(0); \
    BAR(); RESC(alC); }
  for (int j = 1; j < NT; j += 4) {
    STEP(j,     pB0, pB1, alB, pA0, pA1, alA, 1, 0, 3)
    STEP(j + 1, pA0, pA1, alA, pB0, pB1, alB, 2, 1, 0)
    STEP(j + 2, pB0, pB1, alB, pA0, pA1, alA, 3, 2, 1)
    STEP(j + 3, pA0, pA1, alA, pB0, pB1, alB, 0, 3, 2)
  }
  finishSM8(pB0, pB1, alB, l_reg, pa); SBAR();
  pv8(o, V_lds + 3 * SHM_V8, r32, hi, pa);
  if (hi == 0) li_l[r32] = l_reg; asm volatile("s_waitcnt lgkmcnt(0)" ::: "memory");
  float rli[16];
#pragma unroll
  for (int r = 0; r < 16; ++r) rli[r] = __builtin_amdgcn_rcpf(li_l[crow(r, hi)]);
  TO* Ow = Ob + (long)(wid * QBLK) * LDO;
#pragma unroll
  for (int r = 0; r < 16; ++r) { int orow = crow(r, hi);
    for (int d0 = 0; d0 < 4; ++d0) st_out(&Ow[(long)orow * LDO + d0 * 32 + r32], o[d0][r] * rli[r]); }
#undef GLDS16
#undef DMA
#undef WAITV
#undef BAR
#undef RESC
#undef STEP
}

}
namespace pg {
#define PG_LAS __attribute__((address_space(3)))
typedef unsigned short bf16_t;
typedef short bf16x8 __attribute__((ext_vector_type(8)));
typedef float f32x4 __attribute__((ext_vector_type(4)));
typedef float f32x2 __attribute__((ext_vector_type(2)));
typedef unsigned u32x4 __attribute__((ext_vector_type(4)));
typedef unsigned u32x2 __attribute__((ext_vector_type(2)));
constexpr int BM = 256, BK = 64, HALF = 128, HTB = HALF * BK * 2, STAGE_BYTES = 8 * HTB;

__host__ __device__ __forceinline__ int lds_byte(int r, int c) { const int st = (r >> 4) * 2 + (c >> 5), rr = r & 15, cc = c & 31, ob = rr * 64 + cc * 2; return st * 1024 + (ob ^ (((ob >> 9) & 1) << 5)); }
__host__ __device__ __forceinline__ void stage_rc(int b, int& R, int& C) { const int st = b / 1024, sb = b % 1024, swz = sb ^ (((sb >> 9) & 1) << 5); R = (st >> 1) * 16 + swz / 64; C = (st & 1) * 32 + (swz % 64) / 2; }
__host__ __device__ __forceinline__ int perm32(int rho) { const int n = rho >> 4, i = rho & 15; return 8 * (i >> 2) + 4 * n + (i & 3); }
__device__ __forceinline__ unsigned cvt_pk_bf16(float lo, float hi) { unsigned r; asm volatile("v_cvt_pk_bf16_f32 %0, %1, %2" : "=v"(r) : "v"(lo), "v"(hi)); return r; }
typedef __bf16 bf16x2_t __attribute__((ext_vector_type(2)));
__device__ __forceinline__ unsigned cvt_pk_c(float lo, float hi) { const f32x2 v = {lo, hi}; const bf16x2_t b = __builtin_convertvector(v, bf16x2_t); return __builtin_bit_cast(unsigned, b); }

struct Unit { int pm, pn, z, aux, half; };

typedef int i32x8 __attribute__((ext_vector_type(8)));
template <class Epi, class Prob, bool GATHER, bool FP8 = false, int XM = 0>
__device__ __forceinline__ void gemm_phase(PG_LAS unsigned char* lds, const Prob& S, const Epi& E) {
    const int tid = threadIdx.x, wid = __builtin_amdgcn_readfirstlane(tid >> 6), lane = tid & 63, wr = wid >> 2, wc = wid & 3, fr = lane & 15, fq = lane >> 4;
    int nt = S.K / BK; asm volatile("" : "+s"(nt));
    unsigned voffA[2], voffB[2]; int RA[2], CA[2];
#pragma unroll
    for (int i = 0; i < 2; ++i) { int R, C; stage_rc(tid * 16 + i * 8192, R, C); const int Rb = Epi::PERM ? ((R & ~31) + perm32(R & 31)) : R;
        RA[i] = R; CA[i] = C; voffA[i] = GATHER ? (unsigned)(C * 2) : S.a_off(R, C); voffB[i] = S.b_off(Rb, C); }
    const size_t kstep = (size_t)(BK * 2);
    const size_t hA = GATHER ? 0 : S.hstepA, hB = S.hstepB;
    const unsigned ldsw = (unsigned)wid * 1024u;
    const int aoff = lds_byte(wr * 64 + fr, fq * 8), boff = lds_byte(wc * 32 + fr, fq * 8);
#define PG_SA(b, h) (((b) * 2 + (h)) * HTB)
#define PG_SB(b, h) ((4 + (b) * 2 + (h)) * HTB)
#define PG_GLDS(gptr, ldsoff) if constexpr (!(XM & 4)) __builtin_amdgcn_global_load_lds((const unsigned*)(gptr), (PG_LAS unsigned*)(lds + (ldsoff)), 16, 0, 0)
#define PG_STAGE_A(bufoff, base, G, h, kb) do { const char* _ub = (base) + (kb) + (GATHER ? (size_t)0 : (size_t)(h) * hA); \
        _Pragma("unroll") for (int _i = 0; _i < 2; ++_i) { unsigned _o = GATHER ? (G)[h][_i] : voffA[_i]; asm volatile("" : "+v"(_o)); PG_GLDS(_ub + _o, (bufoff) + ldsw + _i * 8192); } } while (0)
#define PG_STAGE_B(bufoff, base, h, kb) do { const char* _ub = (base) + (kb) + (size_t)(h) * hB; \
        _Pragma("unroll") for (int _i = 0; _i < 2; ++_i) { unsigned _o = voffB[_i]; asm volatile("" : "+v"(_o)); PG_GLDS(_ub + _o, (bufoff) + ldsw + _i * 8192); } } while (0)
#define PG_LDA(dst, b, h) do { if constexpr (!(XM & 2)) _Pragma("unroll") for (int m = 0; m < 4; ++m) _Pragma("unroll") for (int k = 0; k < 2; ++k) dst[m][k] = *(const PG_LAS bf16x8*)(lds + PG_SA(b, h) + aoff + m * 2048 + k * 1024); } while (0)
#define PG_LDB(dst, b, h) do { if constexpr (!(XM & 2)) _Pragma("unroll") for (int n = 0; n < 2; ++n) _Pragma("unroll") for (int k = 0; k < 2; ++k) dst[n][k] = *(const PG_LAS bf16x8*)(lds + PG_SB(b, h) + boff + n * 2048 + k * 1024); } while (0)
#define PG_CAT(x) __builtin_shufflevector(__builtin_bit_cast(u32x4, (x)[0]), __builtin_bit_cast(u32x4, (x)[1]), 0, 1, 2, 3, 4, 5, 6, 7)
#define PG_MMA(ai, bj, At, Bt) do { __builtin_amdgcn_s_setprio(1); _Pragma("unroll") for (int m = 0; m < 4; ++m) _Pragma("unroll") for (int n = 0; n < 2; ++n) { \
        if constexpr ((XM & 1) != 0) { asm volatile("" :: "v"(At[m][0]), "v"(At[m][1]), "v"(Bt[n][0]), "v"(Bt[n][1])); } else \
        if constexpr (FP8) acc[ai][bj][m][n] = __builtin_amdgcn_mfma_scale_f32_16x16x128_f8f6f4(__builtin_bit_cast(i32x8, PG_CAT(Bt[n])), __builtin_bit_cast(i32x8, PG_CAT(At[m])), acc[ai][bj][m][n], 0, 0, 0, 0, 0, 0); \
        else { _Pragma("unroll") for (int k = 0; k < 2; ++k) acc[ai][bj][m][n] = __builtin_amdgcn_mfma_f32_16x16x32_bf16(Bt[n][k], At[m][k], acc[ai][bj][m][n], 0, 0, 0); } } \
        __builtin_amdgcn_s_setprio(0); } while (0)
#define PG_WAIT_V(n) asm volatile("s_waitcnt vmcnt(" #n ")" ::: "memory")
#define PG_WAIT_L(n) asm volatile("s_waitcnt lgkmcnt(" #n ")" ::: "memory")
#define PG_BAR __builtin_amdgcn_s_barrier()
#define PG_SCHED __builtin_amdgcn_sched_barrier(0)
#define PG_AROWS(G, U) do { if (GATHER) { _Pragma("unroll") for (int _h = 0; _h < 2; ++_h) _Pragma("unroll") for (int _i = 0; _i < 2; ++_i) (G)[_h][_i] = S.a_row((U), RA[_i] + 128 * _h) + voffA[_i]; } } while (0)
    Unit cur, nxt; int ui = 0;
    if (!S.next(0, cur)) return;
    f32x4 acc[2][2][4][2];
#pragma unroll
    for (int a = 0; a < 2; ++a)
#pragma unroll
        for (int b = 0; b < 2; ++b)
#pragma unroll
            for (int m = 0; m < 4; ++m)
#pragma unroll
                for (int n = 0; n < 2; ++n) acc[a][b][m][n] = (f32x4){0.f, 0.f, 0.f, 0.f};
    bf16x8 At[4][2], B0[2][2], B1[2][2];
    if constexpr ((XM & 2) != 0) {
#pragma unroll
        for (int q = 0; q < 4; ++q)
#pragma unroll
            for (int k = 0; k < 2; ++k) { u32x4 w; for (int e = 0; e < 4; ++e) w[e] = ((unsigned)(lane + 1) * 0x9E3779B1u + (unsigned)(q * 8 + k * 4 + e + 1) * 0x85EBCA6Bu) & ((XM & 8) ? 0u : 0x7E7E7E7Eu); asm volatile("" : "+v"(w));
                At[q][k] = __builtin_bit_cast(bf16x8, w); if (q < 2) { B0[q][k] = __builtin_bit_cast(bf16x8, w); B1[q][k] = __builtin_bit_cast(bf16x8, w); } }
    }
    unsigned gc[2][2] = {{0u, 0u}, {0u, 0u}}, gn[2][2] = {{0u, 0u}, {0u, 0u}};
    const char* cA = S.a_base(cur); const char* cB = S.b_base(cur);
    PG_AROWS(gc, cur);
    PG_STAGE_B(PG_SB(0, 0), cB, 0, 0); PG_STAGE_B(PG_SB(0, 1), cB, 1, 0); PG_STAGE_A(PG_SA(0, 0), cA, gc, 0, 0); PG_STAGE_A(PG_SA(0, 1), cA, gc, 1, 0);
    if (wr == 1) PG_BAR;
    PG_WAIT_V(2); PG_BAR;
    PG_STAGE_B(PG_SB(1, 0), cB, 0, kstep); PG_STAGE_A(PG_SA(1, 0), cA, gc, 0, kstep); PG_STAGE_B(PG_SB(1, 1), cB, 1, kstep);
    PG_WAIT_V(6); PG_BAR;
    for (;;) {
        const bool has_next = S.next(ui + 1, nxt);
        int hflag = __builtin_amdgcn_readfirstlane(cur.half); asm volatile("" : "+s"(hflag));
        const bool chalf = hflag != 0;
        const char* nA = has_next ? S.a_base(nxt) : cA; const char* nB = has_next ? S.b_base(nxt) : cB;
        if (GATHER) { if (has_next) { PG_AROWS(gn, nxt); } else {
#pragma unroll
            for (int _h = 0; _h < 2; ++_h)
#pragma unroll
                for (int _i = 0; _i < 2; ++_i) gn[_h][_i] = gc[_h][_i]; } }
        for (int t = 0; t < nt; t += 2) {
            const bool last = (t == nt - 2);
            const size_t k1 = (size_t)(t + 1) * kstep;
            const char* a2 = last ? nA : cA + (size_t)(t + 2) * kstep; const char* b2 = last ? nB : cB + (size_t)(t + 2) * kstep;
            unsigned g2[2][2];
#pragma unroll
            for (int _h = 0; _h < 2; ++_h)
#pragma unroll
                for (int _i = 0; _i < 2; ++_i) g2[_h][_i] = last ? gn[_h][_i] : gc[_h][_i];
            PG_LDB(B0, 0, 0); PG_LDB(B1, 0, 1); PG_SCHED; PG_LDA(At, 0, 0); PG_STAGE_A(PG_SA(1, 1), cA, gc, 1, k1);
            PG_WAIT_V(8); PG_WAIT_L(0); PG_BAR; PG_MMA(0, 0, At, B0); PG_MMA(0, 1, At, B1); PG_BAR; PG_SCHED;
            if (!chalf) PG_LDA(At, 0, 1); PG_STAGE_B(PG_SB(0, 0), b2, 0, 0); PG_STAGE_B(PG_SB(0, 1), b2, 1, 0); PG_STAGE_A(PG_SA(0, 0), a2, g2, 0, 0);
            PG_WAIT_V(8); PG_WAIT_L(0); PG_BAR; if (!chalf) { PG_MMA(1, 0, At, B0); PG_MMA(1, 1, At, B1); } PG_BAR; PG_SCHED;
            PG_LDB(B0, 1, 0); PG_LDB(B1, 1, 1); PG_SCHED; PG_LDA(At, 1, 0); PG_STAGE_A(PG_SA(0, 1), a2, g2, 1, 0);
            PG_WAIT_V(8); PG_WAIT_L(0); PG_BAR; PG_MMA(0, 0, At, B0); PG_MMA(0, 1, At, B1); PG_BAR; PG_SCHED;
            if (!chalf) PG_LDA(At, 1, 1); PG_STAGE_B(PG_SB(1, 0), b2, 0, kstep); PG_STAGE_B(PG_SB(1, 1), b2, 1, kstep); PG_STAGE_A(PG_SA(1, 0), a2, g2, 0, kstep);
            PG_WAIT_V(8); PG_WAIT_L(0); PG_BAR; if (!chalf) { PG_MMA(1, 0, At, B0); PG_MMA(1, 1, At, B1); } PG_BAR; PG_SCHED;
        }
        if (wr == 0) PG_BAR;
        E(acc, cur, wr, wc, fr, fq);
        if (!has_next) break;
#pragma unroll
        for (int a = 0; a < 2; ++a)
#pragma unroll
            for (int b = 0; b < 2; ++b)
#pragma unroll
                for (int m = 0; m < 4; ++m)
#pragma unroll
                    for (int n = 0; n < 2; ++n) acc[a][b][m][n] = (f32x4){0.f, 0.f, 0.f, 0.f};
        cur = nxt; cA = nA; cB = nB; ++ui;
        if (GATHER) {
#pragma unroll
            for (int _h = 0; _h < 2; ++_h)
#pragma unroll
                for (int _i = 0; _i < 2; ++_i) gc[_h][_i] = gn[_h][_i]; }
        if (wr == 1) PG_BAR;
    }
    PG_WAIT_V(0);
    PG_BAR;
#undef PG_SA
#undef PG_SB
#undef PG_GLDS
#undef PG_STAGE_A
#undef PG_STAGE_B
#undef PG_LDA
#undef PG_LDB
#undef PG_MMA
#undef PG_CAT
#undef PG_WAIT_V
#undef PG_WAIT_L
#undef PG_BAR
#undef PG_SCHED
#undef PG_AROWS
}
}
namespace mk {
#define GAS __attribute__((address_space(1)))
#define LAS __attribute__((address_space(3)))
typedef unsigned short bf16;
typedef float f32x4 __attribute__((ext_vector_type(4)));
typedef float f32x2 __attribute__((ext_vector_type(2)));
typedef short bf16x8 __attribute__((ext_vector_type(8)));
typedef unsigned u32x4 __attribute__((ext_vector_type(4)));
typedef unsigned u32x2 __attribute__((ext_vector_type(2)));
using pg::cvt_pk_bf16;

constexpr int D = 2048, SEQ = 16384, CTX = 256, T = SEQ + CTX, NE = 32, DE = 1024, CAP = T;
constexpr int NWAVES = 8, NTHR = 512;
#ifndef MK_MOE_FP8
#define MK_MOE_FP8 1
#endif
#ifndef MK_ATT_FP8
#define MK_ATT_FP8 1
#endif
#ifndef MK_ATT_PV8
#define MK_ATT_PV8 1
#endif
constexpr bool ATT_FP8 = MK_ATT_FP8 != 0;
constexpr bool ATT_PV8 = ATT_FP8 && (MK_ATT_PV8 != 0);
#ifndef MK_D8
#define MK_D8 6
#endif
constexpr bool CIN_FP8 = (MK_D8 & 1) != 0, QKV_FP8 = (MK_D8 & 2) != 0, GLU_FP8 = (MK_D8 & 4) != 0;
constexpr float D8_WSCALE = 32.f;
constexpr bool MOE_FP8 = MK_MOE_FP8 != 0;
constexpr int MOE_EB = MOE_FP8 ? 1 : 2;
constexpr float MOE_WSCALE = MOE_FP8 ? 32.f : 1.f;
constexpr int MT = T / 256;
constexpr int ACT_ROWS = T * 4 + NE * 256;

constexpr size_t al256(size_t x) { return (x + 255) / 256 * 256; }
constexpr size_t WS_CTL = 0, CTL_BYTES = 1u << 20;
constexpr int CW_BAR = 1024;
constexpr int CW_CNT = 8192;
constexpr int CW_MOD = 16384;
static_assert((CW_MOD + 4 * 2 * 6 * D) * 4 <= (int)CTL_BYTES, "ctl");
constexpr size_t WS_WT_F = CTL_BYTES;
constexpr size_t WS_WT_CIN = WS_WT_F + (size_t)D * D * 2;
constexpr size_t WS_WT_COUT = WS_WT_CIN + (size_t)3 * D * D * 2;
constexpr size_t WS_WT_QKV = WS_WT_COUT + (size_t)D * D * 2;
constexpr size_t WS_WT_WO = WS_WT_QKV + (size_t)3072 * D * 2;
constexpr size_t WS_WT_GLU = WS_WT_WO + (size_t)D * D * 2;
constexpr size_t WS_WT_W1 = WS_WT_GLU + (size_t)2 * D * D * 2;
constexpr size_t WS_WT_W2 = WS_WT_W1 + (size_t)4 * NE * 2 * DE * D * 2;
constexpr size_t WS_DT = WS_WT_W2 + (size_t)4 * NE * D * DE * 2;
constexpr size_t WS_DM1 = WS_DT + 512 * 256 * 2;
constexpr size_t WS_DM2 = WS_DM1 + 256 * 256 * 2;
constexpr size_t WS_DM256 = WS_DM2 + 256 * 256 * 2;
constexpr size_t WS_X = WS_DM256 + 256 * 512 * 2;
constexpr size_t WS_H = WS_X + (size_t)T * D * 4;
constexpr size_t WS_H2 = WS_H + (size_t)T * D * 2;
constexpr size_t WS_REC = WS_H2 + (size_t)T * D * 2;
constexpr size_t WS_GATE = WS_REC + (size_t)T * 4 * 8;
constexpr size_t WS_TOKL = WS_GATE + (size_t)T * 4 * 4;
constexpr size_t WS_ACT = al256(WS_TOKL + (size_t)NE * CAP * 4);
constexpr size_t WS_YB = WS_ACT + (size_t)ACT_ROWS * DE * 2;
constexpr size_t WS_ARENA = al256(WS_YB + (size_t)ACT_ROWS * D * 2);
constexpr size_t AR_L1 = 0;
constexpr size_t AR_LC = AR_L1 + (size_t)128 * 4096 * 128 * 2;
constexpr size_t AR_L2 = AR_LC + (size_t)4096 * 256 * 2;
constexpr size_t AR_F = AR_L2 + (size_t)128 * 4096 * 128 * 2;
constexpr size_t AR_GB = 0, AR_S = AR_GB + (size_t)T * D * 2, AR_A2 = AR_S + (size_t)T * D * 2;
constexpr size_t AR_QR = 0, AR_KR = AR_QR + (size_t)T * D * 2, AR_VR = AR_KR + (size_t)T * 512 * 2, AR_QB = AR_VR + (size_t)T * 512 * 2,
                 AR_KB = AR_QB + (size_t)T * D * 2, AR_VB = AR_KB + (size_t)T * 512 * 2, AR_O = AR_VB + (size_t)T * 512 * 2, AR_V8T = AR_O + (size_t)T * D * 2;
constexpr size_t AR_YD = 0, AR_Z = AR_YD + (size_t)2 * SEQ * D * 4, AR_SS = AR_Z + (size_t)SEQ * D * 2;
constexpr size_t AR_SS_END = AR_SS + (size_t)256 * 1040 * 128 * 4;
constexpr size_t AR_END = (AR_F + (size_t)T * D * 2) > AR_SS_END ? (AR_F + (size_t)T * D * 2) : AR_SS_END;
constexpr size_t WS_FAST_END = WS_ARENA + AR_END;

constexpr int RING_BYTES = 131072;
constexpr int SCR_BYTES = 8 * 128 * 33 * 4;
constexpr int MISC_OFF = 139264;
constexpr int LDS_BYTES = 147456;
static_assert(SCR_BYTES <= MISC_OFF && RING_BYTES <= MISC_OFF && MISC_OFF + 8192 <= LDS_BYTES, "LDS map");

#define XB_TMO      128
#define XB_XCNT(j)  (256  + 64 * (j))
#define XB_XSUB(j)  (1280 + 64 * (j))
#define XB_XGEN(j)  (2304 + 64 * (j))
#define XB_TOP      3328
#define XB_TOPGEN   3392
#define XCD_BAR_WORDS 3456
#define XB_SPIN_CAP (1u << 18)
__device__ __forceinline__ unsigned xb_ld(unsigned* p)              { return __hip_atomic_load(p, __ATOMIC_RELAXED, __HIP_MEMORY_SCOPE_AGENT); }
__device__ __forceinline__ unsigned xb_add(unsigned* p, unsigned v) { return __hip_atomic_fetch_add(p, v, __ATOMIC_RELAXED, __HIP_MEMORY_SCOPE_AGENT); }
__device__ __forceinline__ unsigned xb_xcc_id() { return (unsigned)__builtin_amdgcn_s_getreg((3 << 11) | 20) & 0xFu; }
#define XB_SPIN(cond, bar) do { unsigned _sp = 0; while (cond) { __builtin_amdgcn_s_sleep(1); \
    if ((++_sp & 255u) == 0u) { if (xb_ld(&(bar)[XB_TMO])) break; if (_sp > XB_SPIN_CAP) { atomicAdd(&(bar)[XB_TMO], 1u); break; } } } } while (0)
struct XcdBarrier { unsigned* bar; unsigned x; volatile LAS unsigned* st; };
__device__ __forceinline__ XcdBarrier xcd_barrier_post(unsigned* bar, volatile LAS unsigned* st) {
    XcdBarrier b; b.bar = bar; b.x = xb_xcc_id(); b.st = st;
    if (threadIdx.x == 0) (void)xb_add(&bar[XB_XCNT(b.x)], 1u);
    return b;
}
__device__ __forceinline__ void xcd_barrier_complete(unsigned* bar, unsigned x, unsigned& nloc, unsigned& nx) {
    const unsigned G = gridDim.x * gridDim.y * gridDim.z;
    unsigned sum, cnt, mine, sp = 0u;
    for (;;) {
        sum = 0u; cnt = 0u; mine = 0u;
#pragma unroll
        for (unsigned j = 0; j < 16; ++j) { const unsigned c = xb_ld(&bar[XB_XCNT(j)]); sum += c; cnt += (c > 0u) ? 1u : 0u; mine = (j == x) ? c : mine; }
        if (sum == G) break;
        __builtin_amdgcn_s_sleep(1);
        if ((++sp & 255u) == 0u) { if (xb_ld(&bar[XB_TMO])) break; if (sp > XB_SPIN_CAP) { atomicAdd(&bar[XB_TMO], 1u); break; } }
    }
    nloc = mine > 0u ? mine : 1u; nx = cnt > 0u ? cnt : 1u;
}
__device__ __forceinline__ void xcd_barrier(const XcdBarrier& b) {
    asm volatile("s_waitcnt vmcnt(0)" ::: "memory");
    __syncthreads();
    if (threadIdx.x == 0) {
        unsigned* bar = b.bar;
        __builtin_amdgcn_s_waitcnt(0);
        unsigned nloc = b.st[0], nx = b.st[1];
        if (nloc == 0u) { xcd_barrier_complete(bar, b.x, nloc, nx); b.st[0] = nloc; b.st[1] = nx; }
        const unsigned old = xb_add(&bar[XB_XSUB(b.x)], 1u);
        const unsigned gen = old / nloc;
        if (old + 1u == (gen + 1u) * nloc) {
            __builtin_amdgcn_fence(__ATOMIC_RELEASE, "agent");
            asm volatile("s_waitcnt vmcnt(0)" ::: "memory");
            const unsigned og = xb_add(&bar[XB_TOP], 1u);
            const unsigned tg = og / nx;
            if (og + 1u == (tg + 1u) * nx) xb_add(&bar[XB_TOPGEN], 1u);
            else XB_SPIN(xb_ld(&bar[XB_TOPGEN]) == tg, bar);
            __builtin_amdgcn_fence(__ATOMIC_ACQUIRE, "agent");
            xb_add(&bar[XB_XGEN(b.x)], 1u);
            asm volatile("s_waitcnt vmcnt(0)" ::: "memory");
        } else {
            XB_SPIN(xb_ld(&bar[XB_XGEN(b.x)]) == gen, bar);
            __builtin_amdgcn_fence(__ATOMIC_ACQUIRE, "agent");
            asm volatile("s_waitcnt vmcnt(0)" ::: "memory");
        }
    }
    __syncthreads();
}

struct Args { const float* in[36]; float* out; unsigned char* ws; const float* xin; int ph_lo, ph_hi; };
struct Frame {
    LAS unsigned char* lds; volatile LAS unsigned* MISC;
    unsigned* ctl; unsigned char* ws; unsigned char* ar;
    int tid, lane, wave, vcu, G, gw, NGW;
};
template <int CTRL> __device__ __forceinline__ float dpp_get(float v) { return __int_as_float(__builtin_amdgcn_update_dpp(0, __float_as_int(v), CTRL, 0xf, 0xf, true)); }
__device__ __forceinline__ float wave_sum(float v) {
    v += dpp_get<0xB1>(v); v += dpp_get<0x4E>(v); v += dpp_get<0x124>(v); v += dpp_get<0x128>(v);
    v += __int_as_float(__builtin_amdgcn_ds_swizzle(__float_as_int(v), 0x401f));
    { const auto rr = __builtin_amdgcn_permlane32_swap(__float_as_uint(v), __float_as_uint(v), false, false); v = __uint_as_float(rr[0]) + __uint_as_float(rr[1]); }
    return v;
}
__device__ __forceinline__ float silu_f(float x) { return x * __builtin_amdgcn_rcpf(1.f + __expf(-x)); }
__device__ __forceinline__ float sigm_f(float x) { return __builtin_amdgcn_rcpf(1.f + __expf(-x)); }
__device__ __forceinline__ float gelu_tanh_f(float x) { const float u = 0.7978845608028654f * (x + 0.044715f * x * x * x); const float e = __expf(2.f * u); return 0.5f * x * (1.f + (1.f - 2.f * __builtin_amdgcn_rcpf(e + 1.f))); }
__device__ __forceinline__ float bf2f(unsigned short b) { return __uint_as_float(((unsigned)b) << 16); }
__device__ __forceinline__ float bflo(unsigned w) { return __uint_as_float(w << 16); }
__device__ __forceinline__ float bfhi(unsigned w) { return __uint_as_float(w & 0xffff0000u); }
}
namespace mk {
struct TrIt { const float* W; bf16* WT; int ldw, K, N, hs, roff, r, f8; };
constexpr int TR_SCR = 128 * 33 * 4;
__device__ __forceinline__ void tr_load(const TrIt& d, f32x4 (&v)[16], int lane) {
    if (d.f8 == 2) { const int nblk = d.N / 32, kb = d.r / nblk, nb = d.r % nblk, k0 = 128 * kb, n0 = 32 * nb;
#pragma unroll
        for (int j = 0; j < 16; ++j) v[j] = __builtin_nontemporal_load((const GAS f32x4*)(d.W + (size_t)(k0 + (lane >> 3) + 8 * j) * d.ldw + n0 + 4 * (lane & 7)));
        return; }
    const int nblk = d.N / 64, kb = d.r / nblk, nb = d.r % nblk, k0 = 64 * kb, n0 = 64 * nb;
#pragma unroll
    for (int j = 0; j < 16; ++j) v[j] = __builtin_nontemporal_load((const GAS f32x4*)(d.W + (size_t)(k0 + (lane >> 4) + 4 * j) * d.ldw + n0 + 4 * (lane & 15)));
}
__device__ __forceinline__ void tr_store(const TrIt& d, const f32x4 (&v)[16], LAS float* scr, int lane) {
    if (d.f8 == 2) { const int nblk = d.N / 32, kb = d.r / nblk, nb = d.r % nblk, k0 = 128 * kb, n0 = 32 * nb;
#pragma unroll
        for (int j = 0; j < 16; ++j) { LAS float* s = scr + ((lane >> 3) + 8 * j) * 33 + 4 * (lane & 7); s[0] = v[j].x; s[1] = v[j].y; s[2] = v[j].z; s[3] = v[j].w; }
        asm volatile("s_waitcnt lgkmcnt(0)" ::: "memory");
        int nrow0;
        if (d.hs) { const int h = n0 / d.hs, j = n0 % d.hs; nrow0 = (j / 128) * 256 + h * 128 + (j % 128); } else nrow0 = n0;
        nrow0 += d.roff;
        const int c = lane & 7;
#pragma unroll
        for (int j = 0; j < 4; ++j) { const int n = (lane >> 3) + 8 * j; const LAS float* s = scr + (16 * c) * 33 + n; u32x4 o;
#pragma unroll
            for (int q = 0; q < 4; ++q) { int w = __builtin_amdgcn_cvt_pk_fp8_f32(s[(4 * q) * 33] * 32.f, s[(4 * q + 1) * 33] * 32.f, 0, false); w = __builtin_amdgcn_cvt_pk_fp8_f32(s[(4 * q + 2) * 33] * 32.f, s[(4 * q + 3) * 33] * 32.f, w, true); o[q] = (unsigned)w; }
            __builtin_nontemporal_store(o, (GAS u32x4*)((unsigned char*)d.WT + (size_t)(nrow0 + n) * d.K + k0 + 16 * c)); }
        asm volatile("s_waitcnt lgkmcnt(0)" ::: "memory");
        return; }
    const int nblk = d.N / 64, kb = d.r / nblk, nb = d.r % nblk, k0 = 64 * kb, n0 = 64 * nb;
#pragma unroll
    for (int j = 0; j < 16; ++j) { LAS float* s = scr + ((lane >> 4) + 4 * j) * 65 + 4 * (lane & 15); s[0] = v[j].x; s[1] = v[j].y; s[2] = v[j].z; s[3] = v[j].w; }
    asm volatile("s_waitcnt lgkmcnt(0)" ::: "memory");
    int nrow0;
    if (d.hs) { const int h = n0 / d.hs, j = n0 % d.hs; nrow0 = (j / 128) * 256 + h * 128 + (j % 128); } else nrow0 = n0;
    nrow0 += d.roff;
    const int c = lane & 7;
    if (d.f8) {
#pragma unroll
        for (int j = 0; j < 8; ++j) { const int n = (lane >> 3) + 8 * j; const LAS float* s = scr + (8 * c) * 65 + n;
            int w0 = __builtin_amdgcn_cvt_pk_fp8_f32(s[0 * 65] * 32.f, s[1 * 65] * 32.f, 0, false); w0 = __builtin_amdgcn_cvt_pk_fp8_f32(s[2 * 65] * 32.f, s[3 * 65] * 32.f, w0, true);
            int w1 = __builtin_amdgcn_cvt_pk_fp8_f32(s[4 * 65] * 32.f, s[5 * 65] * 32.f, 0, false); w1 = __builtin_amdgcn_cvt_pk_fp8_f32(s[6 * 65] * 32.f, s[7 * 65] * 32.f, w1, true);
            __builtin_nontemporal_store((u32x2){(unsigned)w0, (unsigned)w1}, (GAS u32x2*)((unsigned char*)d.WT + (size_t)(nrow0 + n) * d.K + k0 + 8 * c)); }
    } else {
#pragma unroll
        for (int j = 0; j < 8; ++j) { const int n = (lane >> 3) + 8 * j; const LAS float* s = scr + (8 * c) * 65 + n;
            u32x4 o; o.x = cvt_pk_bf16(s[0 * 65], s[1 * 65]); o.y = cvt_pk_bf16(s[2 * 65], s[3 * 65]); o.z = cvt_pk_bf16(s[4 * 65], s[5 * 65]); o.w = cvt_pk_bf16(s[6 * 65], s[7 * 65]);
            __builtin_nontemporal_store(o, (GAS u32x4*)(d.WT + (size_t)(nrow0 + n) * d.K + k0 + 8 * c)); }
    }
    asm volatile("s_waitcnt lgkmcnt(0)" ::: "memory");
}

constexpr int TR_I_DD = (D / 64) * (D / 64), TR_I_D2D = (D / 64) * (2 * D / 64), TR_I_DK = (D / 64) * (512 / 64);
constexpr int TR_I_W1 = (D / 64) * (2 * DE / 64), TR_I_W2 = (DE / 64) * (D / 64);
constexpr int TR_N_SMALL = 4 * TR_I_DD + 2 * TR_I_D2D + TR_I_DD + 2 * TR_I_DK, TR_NL = NE * (TR_I_W1 + TR_I_W2);
__device__ __forceinline__ int tr_moe_lo(int l) { return TR_N_SMALL + l * TR_NL; }
__device__ __forceinline__ TrIt tr_decode(const Args& a, unsigned char* ws, int it) {
    int r = it;
#define TR_ITEM(cnt, W, ldw, K, N, WT, hs, roff, f8) if (r < (cnt)) return TrIt{(W), (WT), (ldw), (K), (N), (hs), (roff), r, (f8)}; r -= (cnt);
    TR_ITEM(TR_I_DD,  a.in[8],      D,     D, D,     (bf16*)(ws + WS_WT_F),    0, 0, 0)
    TR_ITEM(TR_I_DD,  a.in[10],     3 * D, D, D,     (bf16*)(ws + WS_WT_CIN),  0, 0, CIN_FP8 ? 1 : 0)
    TR_ITEM(TR_I_D2D, a.in[10] + D, 3 * D, D, 2 * D, (bf16*)(ws + WS_WT_CIN),  D, D, CIN_FP8 ? 1 : 0)
    TR_ITEM(TR_I_DD,  a.in[13],     D,     D, D,     (bf16*)(ws + WS_WT_COUT), 0, 0, 0)
    TR_ITEM(TR_I_DD,  a.in[14],     D,     D, D,     (bf16*)(ws + WS_WT_QKV),  0, 0, QKV_FP8 ? 1 : 0)
    TR_ITEM(TR_I_DK,  a.in[15],     512,   D, 512,   (bf16*)(ws + WS_WT_QKV),  0, 2048, QKV_FP8 ? 1 : 0)
    TR_ITEM(TR_I_DK,  a.in[16],     512,   D, 512,   (bf16*)(ws + WS_WT_QKV),  0, 2560, QKV_FP8 ? 1 : 0)
    TR_ITEM(TR_I_DD,  a.in[17],     D,     D, D,     (bf16*)(ws + WS_WT_WO),   0, 0, 0)
    TR_ITEM(TR_I_D2D, a.in[28],     2 * D, D, 2 * D, (bf16*)(ws + WS_WT_GLU),  D, 0, GLU_FP8 ? 1 : 0)
#undef TR_ITEM
    const int l = r / TR_NL; r -= l * TR_NL;
    if (r < NE * TR_I_W1) { const int b = l * NE + r / TR_I_W1; return TrIt{a.in[32] + (size_t)b * D * 2 * DE, (bf16*)(ws + WS_WT_W1 + (size_t)b * 2 * DE * D * MOE_EB), 2 * DE, D, 2 * DE, DE, 0, r % TR_I_W1, MOE_FP8 ? 2 : 0}; }
    r -= NE * TR_I_W1;
    { const int b = l * NE + r / TR_I_W2; return TrIt{a.in[34] + (size_t)b * DE * D, (bf16*)(ws + WS_WT_W2 + (size_t)b * D * DE * MOE_EB), D, DE, D, 0, 0, r % TR_I_W2, MOE_FP8 ? 2 : 0}; }
}
#ifdef MK_EXP
__device__ __forceinline__ void read_items(Frame& F, const Args& a, int lo, int hi, int widx, int wstride) {
    unsigned acc = 0u;
    for (int it = lo + widx; it < hi; it += 2 * wstride) {
        TrIt c0 = tr_decode(a, F.ws, it); f32x4 va[16], vb[16];
        tr_load(c0, va, F.lane);
        const bool has = it + wstride < hi;
        if (has) { TrIt c1 = tr_decode(a, F.ws, it + wstride); tr_load(c1, vb, F.lane); }
#pragma unroll
        for (int j = 0; j < 16; ++j) acc ^= __float_as_uint(va[j].x) ^ __float_as_uint(va[j].w);
        if (has) {
#pragma unroll
            for (int j = 0; j < 16; ++j) acc ^= __float_as_uint(vb[j].y) ^ __float_as_uint(vb[j].z); }
    }
    if (acc == 0x12345678u) F.ctl[CW_MOD + 4 * 2 * 6 * D + 64] = acc;
}
#endif
__device__ __forceinline__ void convert_items(Frame& F, const Args& a, int lo, int hi, int widx, int wstride) {
    LAS float* scr = (LAS float*)(F.lds + F.wave * TR_SCR);
    int it = lo + widx;
    if (it >= hi) return;
    f32x4 va[16], vb[16];
    TrIt ca = tr_decode(a, F.ws, it), cb = ca;
    tr_load(ca, va, F.lane);
    for (;;) {
        const int i1 = it + wstride; const bool h1 = i1 < hi;
        if (h1) { cb = tr_decode(a, F.ws, i1); tr_load(cb, vb, F.lane); }
        tr_store(ca, va, scr, F.lane);
        if (!h1) break;
        const int i2 = i1 + wstride; const bool h2 = i2 < hi;
        if (h2) { ca = tr_decode(a, F.ws, i2); tr_load(ca, va, F.lane); }
        tr_store(cb, vb, scr, F.lane);
        if (!h2) break;
        it = i2;
    }
}
constexpr int BG_F0 = 22;
constexpr int BG_F1A = 30, BG_F1B = 52;
constexpr int BG_F2A = 22, BG_F2B = 44;

__device__ __forceinline__ void p0_prologue(Frame& F, const Args& a) {
    unsigned char* ws = F.ws;
    {
        convert_items(F, a, 0, TR_N_SMALL, F.gw, F.NGW);
        convert_items(F, a, tr_moe_lo(0) + (TR_NL / 64) * BG_F0, tr_moe_lo(1), F.gw, F.NGW);
        convert_items(F, a, tr_moe_lo(1) + (TR_NL / 64) * BG_F1B, tr_moe_lo(2), F.gw, F.NGW);
        convert_items(F, a, tr_moe_lo(2) + (TR_NL / 64) * BG_F2B, tr_moe_lo(4), F.gw, F.NGW);
    }
    {
        bf16* DT = (bf16*)(ws + WS_DT); bf16* DM1 = (bf16*)(ws + WS_DM1); bf16* DM2 = (bf16*)(ws + WS_DM2); bf16* DM256 = (bf16*)(ws + WS_DM256);
        const int gt = F.gw * 64 + F.lane, NGT = F.NGW * 64;
        for (int i = gt; i < 512 * 256; i += NGT) {
            const int mm = i >> 8, k = i & 255, chp = mm >> 1, c = mm & 1; const float x = (float)((chp * k) & 255) * (1.f / 256.f);
            const float v = c ? -__builtin_amdgcn_sinf(x) : __builtin_amdgcn_cosf(x);
            DT[i] = (bf16)(cvt_pk_bf16(v, 0.f) & 0xffffu);
        }
        for (int i = gt; i < 256 * 256; i += NGT) {
            const int row = i >> 8, col = i & 255, cp = row >> 7, p = row & 127, c = col >> 7, aa = col & 127;
            const float x = (float)((p * aa) & 127) * (1.f / 128.f); const float cs = __builtin_amdgcn_cosf(x), sn = __builtin_amdgcn_sinf(x);
            const float v1 = (cp == c) ? cs : (cp == 0 ? sn : -sn);
            DM1[i] = (bf16)(cvt_pk_bf16(v1, 0.f) & 0xffffu);
            const float v2 = (row < 128) ? (c == 0 ? cs : sn) : 0.f;
            DM2[i] = (bf16)(cvt_pk_bf16(v2, 0.f) & 0xffffu);
        }
        for (int i = gt; i < 256 * 512; i += NGT) {
            const int k = i >> 9, col = i & 511, c = col >> 8, n = col & 255; const float x = (float)((k * n) & 255) * (1.f / 256.f);
            const float v = c ? __builtin_amdgcn_sinf(x) : __builtin_amdgcn_cosf(x);
            DM256[i] = (bf16)(cvt_pk_bf16(v, 0.f) & 0xffffu);
        }
    }
    {
        float* MOD = (float*)(F.ctl + CW_MOD);
        const float* c = a.in[1]; const float* cc = a.in[3]; const float* aw = a.in[4]; const float* ab = a.in[5];
        LAS float* sl = (LAS float*)F.lds;
        LAS f32x4* red = (LAS f32x4*)(F.lds + 16384);
        __syncthreads();
        for (int k = F.tid; k < D; k += NTHR) { sl[k] = silu_f(c[k]); sl[D + k] = silu_f(cc[k]); }
        __syncthreads();
        const int NIT = 4 * 192, cq = F.tid & 15, kq = F.tid >> 4;
        for (int it = F.vcu; it < NIT; it += F.G) {
            const int l = it / 192, j = (it % 192) * 64 + 4 * cq;
            const float* w = aw + ((size_t)l * D + kq * 64) * 6 * D + j;
            f32x4 a0 = (f32x4){0.f, 0.f, 0.f, 0.f}, a1 = (f32x4){0.f, 0.f, 0.f, 0.f};
#pragma unroll 1
            for (int k0 = 0; k0 < 64; k0 += 16) {
                f32x4 wv[16];
#pragma unroll
                for (int k = 0; k < 16; ++k) wv[k] = __builtin_nontemporal_load((const GAS f32x4*)(w + (size_t)(k0 + k) * 6 * D));
#pragma unroll
                for (int k = 0; k < 16; ++k) { a0 += sl[kq * 64 + k0 + k] * wv[k]; a1 += sl[D + kq * 64 + k0 + k] * wv[k]; }
            }
            red[kq * 16 + cq] = a0; red[512 + kq * 16 + cq] = a1;
            __syncthreads();
            if (F.tid < 32) { const int w2 = F.tid >> 4, q4 = F.tid & 15; f32x4 sres = *(const GAS f32x4*)(ab + (size_t)l * 6 * D + (it % 192) * 64 + 4 * q4);
#pragma unroll 1
                for (int g2 = 0; g2 < 32; ++g2) sres += red[w2 * 512 + g2 * 16 + q4];
                *(GAS f32x4*)(MOD + ((size_t)l * 2 + w2) * 6 * D + (it % 192) * 64 + 4 * q4) = sres; }
            __syncthreads();
        }
    }
}
}
namespace mk {
__device__ __forceinline__ void norm_phase(Frame& F, const float* Xl, const float* Xc, const float* g, const float* modl, bf16* H, int nrows) {
    for (int row = F.gw; row < nrows; row += F.NGW) {
        const float* xrow = row < SEQ ? Xl + (size_t)row * D : Xc + (size_t)(row - SEQ) * D;
        const float* m = modl + (size_t)(row >= SEQ ? 1 : 0) * 6 * D;
        f32x4 v[8], gg[8], sh[8], sc[8]; float s = 0.f;
#pragma unroll
        for (int j = 0; j < 4; ++j) { const int c = 8 * (F.lane + 64 * j); const GAS f32x4* p = (const GAS f32x4*)(xrow + c); v[2 * j] = p[0]; v[2 * j + 1] = p[1];
            gg[2 * j] = *(const GAS f32x4*)(g + c); gg[2 * j + 1] = *(const GAS f32x4*)(g + c + 4); sh[2 * j] = *(const GAS f32x4*)(m + c); sh[2 * j + 1] = *(const GAS f32x4*)(m + c + 4);
            sc[2 * j] = *(const GAS f32x4*)(m + D + c); sc[2 * j + 1] = *(const GAS f32x4*)(m + D + c + 4); }
#pragma unroll
        for (int j = 0; j < 8; ++j) s += (v[j].x * v[j].x + v[j].y * v[j].y) + (v[j].z * v[j].z + v[j].w * v[j].w);
        const float r = rsqrtf(wave_sum(s) * (1.f / D) + 1e-6f);
#pragma unroll
        for (int j = 0; j < 4; ++j) { const int c = 8 * (F.lane + 64 * j);
            const f32x4 y0 = v[2 * j] * r * gg[2 * j] * (sc[2 * j] + 1.f) + sh[2 * j], y1 = v[2 * j + 1] * r * gg[2 * j + 1] * (sc[2 * j + 1] + 1.f) + sh[2 * j + 1];
            u32x4 w; w.x = cvt_pk_bf16(y0.x, y0.y); w.y = cvt_pk_bf16(y0.z, y0.w); w.z = cvt_pk_bf16(y1.x, y1.y); w.w = cvt_pk_bf16(y1.z, y1.w);
            *(GAS u32x4*)(H + (size_t)row * D + c) = w; }
    }
}

using pg::Unit;
typedef pg::f32x4 (AccT)[2][2][4][2];

struct DenseProb {
    const char* A; const char* Bt; int lda, ldb, K, nM, nN, G, vcu; size_t hstepA, hstepB;
    __device__ __forceinline__ void init(const void* A_, const void* Bt_, int lda_, int ldb_, int K_, int nM_, int nN_, const Frame& F, int Geff = 0) {
        A = (const char*)A_; Bt = (const char*)Bt_; lda = lda_; ldb = ldb_; K = K_; nM = nM_; nN = nN_; G = (Geff > 0 && Geff < F.G) ? Geff : F.G; vcu = F.vcu; hstepA = (size_t)128 * lda * 2; hstepB = (size_t)128 * ldb * 2; }
    __device__ __forceinline__ bool next(int i, Unit& u) const { if (vcu >= G) return false; const int L = i * G + vcu; if (L >= nM * nN) return false; u.pm = L / nN; u.pn = L % nN; u.z = 0; u.aux = 0; u.half = 0; return true; }
    __device__ __forceinline__ const char* a_base(const Unit& u) const { return A + (size_t)u.pm * 256 * lda * 2; }
    __device__ __forceinline__ const char* b_base(const Unit& u) const { return Bt + (size_t)u.pn * 256 * ldb * 2; }
    __device__ __forceinline__ unsigned a_off(int R, int C) const { return (unsigned)(R * lda + C) * 2u; }
    __device__ __forceinline__ unsigned b_off(int R, int C) const { return (unsigned)(R * ldb + C) * 2u; }
    __device__ __forceinline__ unsigned a_row(const Unit&, int) const { return 0u; }
};

template <int LD, int NM, int NN>
struct DenseProbC {
    const char* A; const char* Bt; volatile LAS unsigned* Mz; int K, G, vcu; size_t hstepA, hstepB;
    __device__ __forceinline__ void init(const void* A_, const void* Bt_, const Frame& F, int Geff = 0) {
        A = (const char*)A_; Bt = (const char*)Bt_; Mz = F.MISC + 4; K = LD; G = (Geff > 0 && Geff < F.G) ? Geff : F.G; vcu = F.vcu; hstepA = (size_t)128 * LD * 2; hstepB = (size_t)128 * LD * 2; }
    __device__ __forceinline__ bool next(int i, Unit& u) const { if (vcu >= G) return false; const int L = i * G + vcu + (int)Mz[0]; if (L >= NM * NN) return false; u.pm = L / NN; u.pn = L % NN; u.z = 0; u.aux = 0; u.half = 0; return true; }
    __device__ __forceinline__ const char* a_base(const Unit& u) const { return A + (size_t)u.pm * 256 * LD * 2; }
    __device__ __forceinline__ const char* b_base(const Unit& u) const { return Bt + (size_t)u.pn * 256 * LD * 2; }
    __device__ __forceinline__ unsigned a_off(int R, int C) const { return (unsigned)(R * LD + C) * 2u; }
    __device__ __forceinline__ unsigned b_off(int R, int C) const { return (unsigned)(R * LD + C) * 2u; }
    __device__ __forceinline__ unsigned a_row(const Unit&, int) const { return 0u; }
};

template <bool BASE32>
struct EpiResid {
    static constexpr bool PERM = true;
    bf16* X; const float* bias; const float* gate_lat; const float* gate_ctx; const void* Bl; const void* Bc;
    __device__ __forceinline__ void operator()(const AccT& acc, const Unit& u, int wr, int wc, int fr, int fq) const {
        const int row0 = u.pm * 256 + wr * 64 + fr, col0 = u.pn * 256 + wc * 32 + 8 * fq;
        const bool isctx = (u.pm * 256 >= SEQ);
        const float* gt = isctx ? gate_ctx : gate_lat;
        const float* bs32 = isctx ? (const float*)Bc - (size_t)SEQ * D : (const float*)Bl;
        const bf16* bs16 = isctx ? (const bf16*)Bc - (size_t)SEQ * D : (const bf16*)Bl;
        f32x4 bv[2][2], gv[2][2];
#pragma unroll
        for (int bj = 0; bj < 2; ++bj)
#pragma unroll
            for (int n = 0; n < 2; ++n) { bv[bj][n] = bias ? *(const GAS f32x4*)(bias + col0 + bj * 128 + n * 4) : (f32x4){0.f, 0.f, 0.f, 0.f}; gv[bj][n] = *(const GAS f32x4*)(gt + col0 + bj * 128 + n * 4); }
#pragma unroll
        for (int ai = 0; ai < 2; ++ai)
#pragma unroll
            for (int m = 0; m < 4; ++m) { const size_t off = (size_t)(row0 + ai * 128 + m * 16) * D + col0;
#pragma unroll
                for (int bj = 0; bj < 2; ++bj) { f32x4 b0, b1;
                    if constexpr (BASE32) { b0 = *(const GAS f32x4*)(bs32 + off + bj * 128); b1 = *(const GAS f32x4*)(bs32 + off + bj * 128 + 4); }
                    else { const u32x4 w = *(const GAS u32x4*)(bs16 + off + bj * 128); b0 = (f32x4){bflo(w.x), bfhi(w.x), bflo(w.y), bfhi(w.y)}; b1 = (f32x4){bflo(w.z), bfhi(w.z), bflo(w.w), bfhi(w.w)}; }
                    const f32x4 r0 = b0 + gv[bj][0] * (acc[ai][bj][m][0] + bv[bj][0]), r1 = b1 + gv[bj][1] * (acc[ai][bj][m][1] + bv[bj][1]);
                    u32x4 o; o.x = cvt_pk_bf16(r0.x, r0.y); o.y = cvt_pk_bf16(r0.z, r0.w); o.z = cvt_pk_bf16(r1.x, r1.y); o.w = cvt_pk_bf16(r1.z, r1.w);
                    *(GAS u32x4*)(X + off + bj * 128) = o; } }
    }
};

struct CdftProb {
    const char* DT; const char* H; int K, G, vcu; size_t hstepA, hstepB;
    __device__ __forceinline__ void init(const void* DT_, const void* H_, const Frame& F) { DT = (const char*)DT_; H = (const char*)H_; K = 256; G = F.G; vcu = F.vcu; hstepA = (size_t)128 * 256 * 2; hstepB = (size_t)D * 2; }
    __device__ __forceinline__ bool next(int i, Unit& u) const { const int L = i * G + vcu; if (L >= 16 * 64) return false; u.pm = L / 64; u.pn = L % 64; u.z = 0; u.aux = 0; u.half = 0; return true; }
    __device__ __forceinline__ const char* a_base(const Unit& u) const { return DT + (size_t)(u.pm & 1) * 256 * 256 * 2; }
    __device__ __forceinline__ const char* b_base(const Unit& u) const { return H + (size_t)(2 * u.pn) * D * 2 + (size_t)(u.pm >> 1) * 256 * 2; }
    __device__ __forceinline__ unsigned a_off(int R, int C) const { return (unsigned)(R * 256 + C) * 2u; }
    __device__ __forceinline__ unsigned b_off(int R, int C) const { return (unsigned)((size_t)R * 128 * D + C) * 2u; }
    __device__ __forceinline__ unsigned a_row(const Unit&, int) const { return 0u; }
};
struct EpiCdft {
    static constexpr bool PERM = true;
    bf16* L1;
    __device__ __forceinline__ void operator()(const AccT& acc, const Unit& u, int wr, int wc, int fr, int fq) const {
#pragma unroll
        for (int ai = 0; ai < 2; ++ai)
#pragma unroll
            for (int m = 0; m < 4; ++m) { const int mrow = u.pm * 256 + ai * 128 + wr * 64 + m * 16 + fr;
#pragma unroll
                for (int bj = 0; bj < 2; ++bj) { const f32x4 v0 = acc[ai][bj][m][0], v1 = acc[ai][bj][m][1];
                    u32x4 w; w.x = cvt_pk_bf16(v0[0], v0[1]); w.y = cvt_pk_bf16(v0[2], v0[3]); w.z = cvt_pk_bf16(v1[0], v1[1]); w.w = cvt_pk_bf16(v1[2], v1[3]);
                    *(GAS u32x4*)(L1 + ((size_t)(2 * u.pn + bj) * 4096 + mrow) * 128 + wc * 32 + 8 * fq) = w; } }
    }
};
struct CdftCtxProb {
    const char* DT; const char* H; int K, G, vcu; size_t hstepA, hstepB;
    __device__ __forceinline__ void init(const void* DT_, const void* H_, const Frame& F) { DT = (const char*)DT_; H = (const char*)H_; K = 256; G = F.G; vcu = F.vcu; hstepA = (size_t)128 * 256 * 2; hstepB = (size_t)128 * D * 2; }
    __device__ __forceinline__ bool next(int i, Unit& u) const { const int L = i * G + vcu; if (L >= 16) return false; u.pm = L; u.pn = 0; u.z = 0; u.aux = 0; u.half = 0; return true; }
    __device__ __forceinline__ const char* a_base(const Unit& u) const { return DT + (size_t)(u.pm & 1) * 256 * 256 * 2; }
    __device__ __forceinline__ const char* b_base(const Unit& u) const { return H + (size_t)SEQ * D * 2 + (size_t)(u.pm >> 1) * 256 * 2; }
    __device__ __forceinline__ unsigned a_off(int R, int C) const { return (unsigned)(R * 256 + C) * 2u; }
    __device__ __forceinline__ unsigned b_off(int R, int C) const { return (unsigned)(R * D + C) * 2u; }
    __device__ __forceinline__ unsigned a_row(const Unit&, int) const { return 0u; }
};
struct EpiCdftCtx {
    static constexpr bool PERM = true;
    bf16* LC;
    __device__ __forceinline__ void operator()(const AccT& acc, const Unit& u, int wr, int wc, int fr, int fq) const {
#pragma unroll
        for (int ai = 0; ai < 2; ++ai)
#pragma unroll
            for (int m = 0; m < 4; ++m) { const int mrow = u.pm * 256 + ai * 128 + wr * 64 + m * 16 + fr;
#pragma unroll
                for (int bj = 0; bj < 2; ++bj) { const f32x4 v0 = acc[ai][bj][m][0], v1 = acc[ai][bj][m][1];
                    u32x4 w; w.x = cvt_pk_bf16(v0[0], v0[1]); w.y = cvt_pk_bf16(v0[2], v0[3]); w.z = cvt_pk_bf16(v1[0], v1[1]); w.w = cvt_pk_bf16(v1[2], v1[3]);
                    *(GAS u32x4*)(LC + (size_t)mrow * 256 + bj * 128 + wc * 32 + 8 * fq) = w; } }
    }
};
struct Step1Prob {
    const char* DM1; const char* L1; int K, G, vcu; size_t hstepA, hstepB;
    __device__ __forceinline__ void init(const void* DM1_, const void* L1_, const Frame& F) { DM1 = (const char*)DM1_; L1 = (const char*)L1_; K = 256; G = F.G; vcu = F.vcu; hstepA = (size_t)128 * 256 * 2; hstepB = 512; }
    __device__ __forceinline__ bool next(int i, Unit& u) const { const int L = i * G + vcu; if (L >= 1024) return false; u.pm = 0; u.pn = L; u.z = 0; u.aux = 0; u.half = 0; return true; }
    __device__ __forceinline__ const char* a_base(const Unit&) const { return DM1; }
    __device__ __forceinline__ const char* b_base(const Unit& u) const { return L1 + (size_t)u.pn * 1024; }
    __device__ __forceinline__ unsigned a_off(int R, int C) const { return (unsigned)(R * 256 + C) * 2u; }
    __device__ __forceinline__ unsigned b_off(int R, int C) const { return (unsigned)((size_t)R * 2048 * 256 + C) * 2u; }
    __device__ __forceinline__ unsigned a_row(const Unit&, int) const { return 0u; }
};
struct EpiStep1 {
    static constexpr bool PERM = true;
    bf16* L2;
    __device__ __forceinline__ void operator()(const AccT& acc, const Unit& u, int wr, int wc, int fr, int fq) const {
#pragma unroll
        for (int m = 0; m < 4; ++m) { int p = wr * 64 + m * 16 + fr; asm volatile("" : "+v"(p));
#pragma unroll
            for (int n = 0; n < 2; ++n) {
                float cs[4], sn[4];
#pragma unroll
                for (int e = 0; e < 4; ++e) { const int b = wc * 32 + 8 * fq + 4 * n + e; const float x = (float)(p * b) * (1.f / 16384.f); cs[e] = __builtin_amdgcn_cosf(x); sn[e] = __builtin_amdgcn_sinf(x); }
#pragma unroll
                for (int bj = 0; bj < 2; ++bj) {
                    float yr[4], yi[4];
#pragma unroll
                    for (int e = 0; e < 4; ++e) { const float re = acc[0][bj][m][n][e], im = acc[1][bj][m][n][e]; yr[e] = re * cs[e] + im * sn[e]; yi[e] = im * cs[e] - re * sn[e]; }
                    bf16* dst = L2 + (((size_t)p * 2048 + (2 * u.pn + bj)) * 2) * 128 + wc * 32 + 8 * fq + 4 * n;
                    u32x2 w0, w1; w0.x = cvt_pk_bf16(yr[0], yr[1]); w0.y = cvt_pk_bf16(yr[2], yr[3]); w1.x = cvt_pk_bf16(yi[0], yi[1]); w1.y = cvt_pk_bf16(yi[2], yi[3]);
                    *(GAS u32x2*)dst = w0; *(GAS u32x2*)(dst + 128) = w1; }
                __builtin_amdgcn_sched_barrier(0);
            } }
    }
};
struct Step2Prob {
    const char* DM2; const char* L2; int K, G, vcu; size_t hstepA, hstepB;
    __device__ __forceinline__ void init(const void* DM2_, const void* L2_, const Frame& F) { DM2 = (const char*)DM2_; L2 = (const char*)L2_; K = 256; G = F.G; vcu = F.vcu; hstepA = (size_t)128 * 256 * 2; hstepB = (size_t)128 * 256 * 2; }
    __device__ __forceinline__ bool next(int i, Unit& u) const { const int L = i * G + vcu; if (L >= 1024) return false; u.pm = 0; u.z = L / 8; u.pn = L % 8; u.aux = 0; u.half = 0; return true; }
    __device__ __forceinline__ const char* a_base(const Unit&) const { return DM2; }
    __device__ __forceinline__ const char* b_base(const Unit& u) const { return L2 + ((size_t)u.z * 2048 + (size_t)u.pn * 256) * 256 * 2; }
    __device__ __forceinline__ unsigned a_off(int R, int C) const { return (unsigned)(R * 256 + C) * 2u; }
    __device__ __forceinline__ unsigned b_off(int R, int C) const { return (unsigned)(R * 256 + C) * 2u; }
    __device__ __forceinline__ unsigned a_row(const Unit&, int) const { return 0u; }
};
struct EpiStep2 {
    static constexpr bool PERM = true;
    bf16* Fo; float scale;
    __device__ __forceinline__ void operator()(const AccT& acc, const Unit& u, int wr, int wc, int fr, int fq) const {
#pragma unroll
        for (int m = 0; m < 4; ++m) { const int q = wr * 64 + m * 16 + fr; bf16* rowp = Fo + (size_t)(u.z + 128 * q) * D + u.pn * 256 + wc * 32 + 8 * fq;
#pragma unroll
            for (int bj = 0; bj < 2; ++bj) { const f32x4 v0 = acc[0][bj][m][0] * scale, v1 = acc[0][bj][m][1] * scale;
                u32x4 w; w.x = cvt_pk_bf16(v0[0], v0[1]); w.y = cvt_pk_bf16(v0[2], v0[3]); w.z = cvt_pk_bf16(v1[0], v1[1]); w.w = cvt_pk_bf16(v1[2], v1[3]);
                *(GAS u32x4*)(rowp + bj * 128) = w; } }
    }
};
struct SeqCtxProb {
    const char* DM; const char* LC; int K, G, vcu; size_t hstepA, hstepB;
    __device__ __forceinline__ void init(const void* DM_, const void* LC_, const Frame& F) { DM = (const char*)DM_; LC = (const char*)LC_; K = 512; G = F.G; vcu = F.vcu; hstepA = (size_t)128 * 512 * 2; hstepB = (size_t)128 * 512 * 2; }
    __device__ __forceinline__ bool next(int i, Unit& u) const { const int L = i * G + vcu; if (L >= 8) return false; u.pm = 0; u.pn = L; u.z = 0; u.aux = 0; u.half = 0; return true; }
    __device__ __forceinline__ const char* a_base(const Unit&) const { return DM; }
    __device__ __forceinline__ const char* b_base(const Unit& u) const { return LC + (size_t)u.pn * 256 * 512 * 2; }
    __device__ __forceinline__ unsigned a_off(int R, int C) const { return (unsigned)(R * 512 + C) * 2u; }
    __device__ __forceinline__ unsigned b_off(int R, int C) const { return (unsigned)(R * 512 + C) * 2u; }
    __device__ __forceinline__ unsigned a_row(const Unit&, int) const { return 0u; }
};
struct EpiSeqCtx {
    static constexpr bool PERM = true;
    bf16* Fo;
    __device__ __forceinline__ void operator()(const AccT& acc, const Unit& u, int wr, int wc, int fr, int fq) const {
#pragma unroll
        for (int ai = 0; ai < 2; ++ai)
#pragma unroll
            for (int m = 0; m < 4; ++m) { bf16* rowp = Fo + (size_t)(SEQ + ai * 128 + wr * 64 + m * 16 + fr) * D + u.pn * 256 + wc * 32 + 8 * fq;
#pragma unroll
                for (int bj = 0; bj < 2; ++bj) { const f32x4 v0 = acc[ai][bj][m][0] * (1.f / 256.f), v1 = acc[ai][bj][m][1] * (1.f / 256.f);
                    u32x4 w; w.x = cvt_pk_bf16(v0[0], v0[1]); w.y = cvt_pk_bf16(v0[2], v0[3]); w.z = cvt_pk_bf16(v1[0], v1[1]); w.w = cvt_pk_bf16(v1[2], v1[3]);
                    *(GAS u32x4*)(rowp + bj * 128) = w; } }
    }
};
}
namespace mk {
template <int XR = 0>
__device__ __forceinline__ void router_phase(Frame& F, const bf16* X, const float* g, const float* modl, const float* wr_, const float* br_, bf16* H2,
                                             unsigned* cnt, int* tokl, int* rec, float* gates, int nrows) {
    constexpr int RB_LD = 32 * 68;
    LAS float* rowbuf = (LAS float*)F.lds; LAS float* partial = (LAS float*)(F.lds + 69632); LAS float* gtab = (LAS float*)(F.lds + 102400);
    const int e4 = F.lane & 7, ks8 = F.wave * 8 + (F.lane >> 3);
    LAS unsigned* lcnt = (LAS unsigned*)(F.lds + 135168); LAS unsigned* lbase = lcnt + 32; LAS unsigned* lpick = lcnt + 64;
    __syncthreads();
    if (F.tid < 32) lcnt[F.tid] = 0u;
    lpick[F.tid] = 0xffffffffu;
    { float gv[8], scv[8], shv[8];
#pragma unroll
      for (int q = 0; q < 8; ++q) { const int i = F.tid + q * NTHR, w = i >> 11, c = i & (D - 1); const float* m = modl + (size_t)w * 6 * D + (size_t)3 * D; gv[q] = g[c]; scv[q] = m[D + c]; shv[q] = m[c]; }
#pragma unroll
      for (int q = 0; q < 8; ++q) { const int i = F.tid + q * NTHR, w = i >> 11, c = i & (D - 1); gtab[(w * 2 + 0) * D + c] = gv[q] * (1.f + scv[q]); gtab[(w * 2 + 1) * D + c] = shv[q]; } }
    f32x4 wq[32];
#pragma unroll
    for (int i = 0; i < 32; ++i) wq[i] = *(const GAS f32x4*)(wr_ + (size_t)(ks8 * 32 + i) * NE + 4 * e4);
    const float bias = br_[F.lane & 31];
    const int niter = (nrows + 7) / 8;
    f32x4 v[8];
    int it = F.vcu;
    { const int row = it * 8 + F.wave; if (it < niter && row < nrows) { const GAS u32x2* xr = (const GAS u32x2*)(X + (size_t)row * D) + F.lane;
#pragma unroll
        for (int j = 0; j < 8; ++j) { const u32x2 w = xr[64 * j]; v[j] = (f32x4){bflo(w.x), bfhi(w.x), bflo(w.y), bfhi(w.y)}; } } }
    int itl = 0;
    __syncthreads();
    for (; it < niter; it += F.G, ++itl) {
        const int row = it * 8 + F.wave; const bool act = row < nrows;
        if (act) {
            const LAS float* gt = gtab + (row >= SEQ ? 2 * D : 0);
            float s = 0.f;
#pragma unroll
            for (int j = 0; j < 8; ++j) s += (v[j].x * v[j].x + v[j].y * v[j].y) + (v[j].z * v[j].z + v[j].w * v[j].w);
            const float r = rsqrtf(wave_sum(s) * (1.f / D) + 1e-6f);
            GAS u32x2* o = (GAS u32x2*)(H2 + (size_t)row * D) + F.lane;
#pragma unroll
            for (int j = 0; j < 8; ++j) {
                const f32x4 gg = *(const LAS f32x4*)(gt + 4 * (F.lane + 64 * j)), sh = *(const LAS f32x4*)(gt + D + 4 * (F.lane + 64 * j));
                const f32x4 y = v[j] * r * gg + sh;
                if constexpr (MOE_FP8) { int w8 = __builtin_amdgcn_cvt_pk_fp8_f32(y.x, y.y, 0, false); w8 = __builtin_amdgcn_cvt_pk_fp8_f32(y.z, y.w, w8, true); *((GAS unsigned*)((unsigned char*)H2 + (size_t)row * D) + F.lane + 64 * j) = (unsigned)w8; }
                else { u32x2 w; w.x = cvt_pk_bf16(y.x, y.y); w.y = cvt_pk_bf16(y.z, y.w); o[64 * j] = w; }
                { const int c = 4 * (F.lane + 64 * j); *(LAS f32x4*)(rowbuf + F.wave * RB_LD + (c >> 6) * 68 + (c & 63)) = y; }
            }
        }
        { const int nrow = (it + F.G) * 8 + F.wave; if (it + F.G < niter && nrow < nrows) { const GAS u32x2* xr = (const GAS u32x2*)(X + (size_t)nrow * D) + F.lane;
#pragma unroll
            for (int j = 0; j < 8; ++j) { const u32x2 w = xr[64 * j]; v[j] = (f32x4){bflo(w.x), bfhi(w.x), bflo(w.y), bfhi(w.y)}; } } }
        __syncthreads();
#pragma unroll 1
        for (int rr = 0; rr < ((XR & 1) ? 0 : 8); ++rr) {
            const LAS f32x4* xb = (const LAS f32x4*)(rowbuf + rr * RB_LD + (ks8 >> 1) * 68 + 32 * (ks8 & 1));
            f32x4 a0 = (f32x4){0.f, 0.f, 0.f, 0.f}, a1 = (f32x4){0.f, 0.f, 0.f, 0.f};
#pragma unroll
            for (int i = 0; i < 8; ++i) { const f32x4 xv = xb[i]; a0 += xv.x * wq[4 * i]; a1 += xv.y * wq[4 * i + 1]; a0 += xv.z * wq[4 * i + 2]; a1 += xv.w * wq[4 * i + 3]; }
            f32x4 a = a0 + a1;
#pragma unroll
            for (int e = 0; e < 4; ++e) { float t = a[e]; t += dpp_get<0x128>(t); t += __int_as_float(__builtin_amdgcn_ds_swizzle(__float_as_int(t), 0x401f));
                { const auto rr2 = __builtin_amdgcn_permlane32_swap(__float_as_uint(t), __float_as_uint(t), false, false); t = __uint_as_float(rr2[0]) + __uint_as_float(rr2[1]); } a[e] = t; }
            if (F.lane < 8) *(LAS f32x4*)(partial + (rr * 8 + F.wave) * 32 + 4 * e4) = a;
        }
        __syncthreads();
        if (act && !(XR & 2)) {
            LAS float* lgb = partial + 2048 + F.wave * 64;
            float lg = bias;
            if (F.lane < 32) {
#pragma unroll
                for (int k2 = 0; k2 < 8; ++k2) lg += partial[(F.wave * 8 + k2) * 32 + F.lane]; }
            asm volatile("s_waitcnt lgkmcnt(0)" ::: "memory");
            if (F.lane < 32) lgb[F.lane] = lg;
            asm volatile("s_waitcnt lgkmcnt(0)" ::: "memory");
            int rank = 0;
#pragma unroll 1
            for (int q4 = 0; q4 < 8; ++q4) { const f32x4 o = *(const LAS f32x4*)(lgb + 4 * q4); const int e0 = 4 * q4;
                rank += (o.x > lg || (o.x == lg && e0 + 0 < F.lane)) ? 1 : 0; rank += (o.y > lg || (o.y == lg && e0 + 1 < F.lane)) ? 1 : 0;
                rank += (o.z > lg || (o.z == lg && e0 + 2 < F.lane)) ? 1 : 0; rank += (o.w > lg || (o.w == lg && e0 + 3 < F.lane)) ? 1 : 0; }
            if (F.lane < 32 && rank < 4) { ((LAS int*)lgb)[32 + rank] = F.lane; lgb[36 + rank] = lg; }
            asm volatile("s_waitcnt lgkmcnt(0)" ::: "memory");
            const f32x4 tvv = *(const LAS f32x4*)(lgb + 36); const int myk = F.lane & 3;
            const float e1 = __expf(tvv.y - tvv.x), e2x = __expf(tvv.z - tvv.x), e3 = __expf(tvv.w - tvv.x);
            const float inv = 1.f / (1.f + e1 + e2x + e3);
            if (F.lane < 4) {
                const int ee = ((const LAS int*)lgb)[32 + myk]; const float gv = ((myk == 0) ? 1.f : (myk == 1) ? e1 : (myk == 2) ? e2x : e3) * inv;
                if (itl < 16) { const unsigned lp = __hip_atomic_fetch_add(&lcnt[ee], 1u, __ATOMIC_RELAXED, __HIP_MEMORY_SCOPE_WORKGROUP); lpick[(itl * 8 + F.wave) * 4 + myk] = (unsigned)ee | (lp << 8); }
                else { const int pos = (int)atomicAdd(&cnt[ee * 64], 1u); tokl[ee * CAP + pos] = row; rec[(row * 4 + myk) * 2 + 1] = pos; }
                rec[(row * 4 + myk) * 2] = ee; gates[row * 4 + myk] = gv;
            }
        }
    }
    __syncthreads();
    if (F.tid < 32) { const unsigned c = lcnt[F.tid]; lbase[F.tid] = c ? atomicAdd(&cnt[F.tid * 64], c) : 0u; }
    __syncthreads();
    { const unsigned pv = lpick[F.tid];
      if (pv != 0xffffffffu) { const int e = (int)(pv & 255u), k = F.tid & 3, wv = (F.tid >> 2) & 7, il = F.tid >> 5; const int row = (F.vcu + il * F.G) * 8 + wv; const int pos = (int)(lbase[e] + (pv >> 8));
          tokl[e * CAP + pos] = row; rec[(row * 4 + k) * 2 + 1] = pos; } }
}

__device__ __forceinline__ void moe_tables(Frame& F, const unsigned* cnt) {
    volatile LAS unsigned* tb = F.MISC + 64; volatile LAS unsigned* cn = F.MISC + 128; volatile LAS unsigned* hf = F.MISC + 192; volatile LAS unsigned* tf = F.MISC + 256; volatile LAS unsigned* th = F.MISC + 320;
    if (F.wave == 0) {
        const int e = F.lane & 31;
        const unsigned c = __hip_atomic_load(cnt + e * 64, __ATOMIC_RELAXED, __HIP_MEMORY_SCOPE_AGENT);
        const unsigned nt = (c + 255u) / 256u, h = ((c & 255u) != 0u && (c & 255u) <= 128u) ? 1u : 0u, nf = nt - h;
        unsigned inc = nt, incf = nf, inch = h;
#pragma unroll
        for (int o = 1; o < 32; o <<= 1) { const unsigned v = __shfl_up(inc, o, 32), vf = __shfl_up(incf, o, 32), vh = __shfl_up(inch, o, 32); if (e >= o) { inc += v; incf += vf; inch += vh; } }
        if (F.lane < 32) { tb[e] = inc - nt; cn[e] = c; hf[e] = h; tf[e] = incf - nf; th[e] = inch - h; if (e == 31) { tb[NE] = inc; tf[NE] = incf; th[NE] = inch; } }
    }
    __syncthreads();
}
__device__ __forceinline__ bool moe_unit(const volatile LAS unsigned* MISC, int L, Unit& u) {
    const volatile LAS unsigned* tb = MISC + 64; const volatile LAS unsigned* tf = MISC + 256; const volatile LAS unsigned* th = MISC + 320;
    const int tt = L >> 3, nfull = (int)tf[NE]; if (tt >= (int)tb[NE]) return false;
    int e = 0, mt;
    if (tt < nfull) {
#pragma unroll 1
        for (int j = 1; j < NE; ++j) e = ((int)tf[j] <= tt) ? j : e;
        mt = tt - (int)tf[e]; u.half = 0;
    } else { const int hh = tt - nfull;
#pragma unroll 1
        for (int j = 1; j < NE; ++j) e = ((int)th[j] <= hh) ? j : e;
        mt = (int)(tb[e + 1] - tb[e]) - 1; u.half = 1; }
    u.pm = (int)tb[e] + mt; u.pn = L & 7; u.z = e; u.aux = mt; return true;
}
struct Moe1Prob {
    const char* H2; const char* W1; const int* tokl; volatile LAS unsigned* MISCp; volatile LAS unsigned* cn; int K, G, vcu; size_t hstepA, hstepB;
    __device__ __forceinline__ void init(const void* H2_, const void* W1_, const int* tokl_, const Frame& F) { H2 = (const char*)H2_; W1 = (const char*)W1_; tokl = tokl_; MISCp = F.MISC; cn = F.MISC + 128; K = D * MOE_EB / 2; G = F.G; vcu = F.vcu; hstepA = 0; hstepB = (size_t)128 * D * MOE_EB; }
    __device__ __forceinline__ bool next(int i, Unit& u) const { return moe_unit(MISCp, i * G + vcu, u); }
    __device__ __forceinline__ const char* a_base(const Unit&) const { return H2; }
    __device__ __forceinline__ const char* b_base(const Unit& u) const { return W1 + ((size_t)u.z * 2048 + (size_t)u.pn * 256) * D * MOE_EB; }
    __device__ __forceinline__ unsigned a_off(int, int) const { return 0u; }
    __device__ __forceinline__ unsigned b_off(int R, int C) const { return (unsigned)(R * D * MOE_EB + C * 2); }
    __device__ __forceinline__ unsigned a_row(const Unit& u, int r) const { const int idx = u.aux * 256 + r; const int tok = (idx < (int)cn[u.z]) ? tokl[u.z * CAP + idx] : 0; return (unsigned)tok * (unsigned)(D * MOE_EB); }
};
#ifdef MK_EXP
struct Moe1ProbHot : Moe1Prob {
    __device__ __forceinline__ const char* b_base(const Unit&) const { return W1; }
    __device__ __forceinline__ unsigned a_row(const Unit&, int r) const { return (unsigned)r * (unsigned)(D * MOE_EB); }
};
#endif
struct EpiMoe1 {
    static constexpr bool PERM = true;
    bf16* ACT; const float* b1;
    __device__ __forceinline__ void operator()(const AccT& acc, const Unit& u, int wr, int wc, int fr, int fq) const {
        const int j0 = wc * 32 + 8 * fq; const float* bg = b1 + (size_t)u.z * 2 * DE + u.pn * 128 + j0; const float* bl = bg + DE;
        f32x4 bgv[2], blv[2];
#pragma unroll
        for (int n = 0; n < 2; ++n) { bgv[n] = *(const GAS f32x4*)(bg + 4 * n); blv[n] = *(const GAS f32x4*)(bl + 4 * n); }
#pragma unroll
        for (int ai = 0; ai < 2; ++ai) { if (ai == 1 && u.half) break;
#pragma unroll
            for (int m = 0; m < 4; ++m) { const int r = ai * 128 + wr * 64 + m * 16 + fr;
                float o[8];
#pragma unroll
                for (int n = 0; n < 2; ++n)
#pragma unroll
                    for (int e = 0; e < 4; ++e) { float gt = acc[ai][0][m][n][e] * (1.f / MOE_WSCALE) + bgv[n][e], ln = acc[ai][1][m][n][e] * (1.f / MOE_WSCALE) + blv[n][e];
                        gt = fminf(gt, 7.f); ln = fminf(fmaxf(ln, -7.f), 7.f); o[4 * n + e] = (ln + 1.f) * gt * sigm_f(1.702f * gt); }
                if constexpr (MOE_FP8) { int w0 = __builtin_amdgcn_cvt_pk_fp8_f32(o[0], o[1], 0, false); w0 = __builtin_amdgcn_cvt_pk_fp8_f32(o[2], o[3], w0, true); int w1 = __builtin_amdgcn_cvt_pk_fp8_f32(o[4], o[5], 0, false); w1 = __builtin_amdgcn_cvt_pk_fp8_f32(o[6], o[7], w1, true);
                    *(GAS u32x2*)((unsigned char*)ACT + (size_t)(u.pm * 256 + r) * DE + u.pn * 128 + j0) = (u32x2){(unsigned)w0, (unsigned)w1}; }
                else { u32x4 w; w.x = cvt_pk_bf16(o[0], o[1]); w.y = cvt_pk_bf16(o[2], o[3]); w.z = cvt_pk_bf16(o[4], o[5]); w.w = cvt_pk_bf16(o[6], o[7]);
                    *(GAS u32x4*)(ACT + (size_t)(u.pm * 256 + r) * DE + u.pn * 128 + j0) = w; } } }
    }
};
struct Moe2Prob {
    const char* ACT; const char* W2; volatile LAS unsigned* MISCp; int K, G, vcu; size_t hstepA, hstepB;
    __device__ __forceinline__ void init(const void* ACT_, const void* W2_, const Frame& F) { ACT = (const char*)ACT_; W2 = (const char*)W2_; MISCp = F.MISC; K = DE * MOE_EB / 2; G = F.G; vcu = F.vcu; hstepA = (size_t)128 * DE * MOE_EB; hstepB = (size_t)128 * DE * MOE_EB; }
    __device__ __forceinline__ bool next(int i, Unit& u) const { return moe_unit(MISCp, i * G + vcu, u); }
    __device__ __forceinline__ const char* a_base(const Unit& u) const { return ACT + (size_t)u.pm * 256 * DE * MOE_EB; }
    __device__ __forceinline__ const char* b_base(const Unit& u) const { return W2 + ((size_t)u.z * D + (size_t)u.pn * 256) * DE * MOE_EB; }
    __device__ __forceinline__ unsigned a_off(int R, int C) const { return (unsigned)(R * DE * MOE_EB + C * 2); }
    __device__ __forceinline__ unsigned b_off(int R, int C) const { return (unsigned)(R * DE * MOE_EB + C * 2); }
    __device__ __forceinline__ unsigned a_row(const Unit&, int) const { return 0u; }
};
struct EpiMoe2 {
    static constexpr bool PERM = true;
    bf16* YB; const float* b2;
    __device__ __forceinline__ void operator()(const AccT& acc, const Unit& u, int wr, int wc, int fr, int fq) const {
        const int c0 = u.pn * 256 + wc * 32 + 8 * fq; const float* bb = b2 + (size_t)u.z * D + c0;
        f32x4 bv[2][2];
#pragma unroll
        for (int bj = 0; bj < 2; ++bj)
#pragma unroll
            for (int n = 0; n < 2; ++n) bv[bj][n] = *(const GAS f32x4*)(bb + bj * 128 + 4 * n);
#pragma unroll
        for (int ai = 0; ai < 2; ++ai) { if (ai == 1 && u.half) break;
#pragma unroll
            for (int m = 0; m < 4; ++m) { bf16* rowp = YB + (size_t)(u.pm * 256 + ai * 128 + wr * 64 + m * 16 + fr) * D + c0;
#pragma unroll
                for (int bj = 0; bj < 2; ++bj) { const f32x4 v0 = acc[ai][bj][m][0] * (1.f / MOE_WSCALE) + bv[bj][0], v1 = acc[ai][bj][m][1] * (1.f / MOE_WSCALE) + bv[bj][1];
                    if constexpr (MOE_FP8) { int w0 = __builtin_amdgcn_cvt_pk_fp8_f32(v0[0], v0[1], 0, false); w0 = __builtin_amdgcn_cvt_pk_fp8_f32(v0[2], v0[3], w0, true); int w1 = __builtin_amdgcn_cvt_pk_fp8_f32(v1[0], v1[1], 0, false); w1 = __builtin_amdgcn_cvt_pk_fp8_f32(v1[2], v1[3], w1, true);
                        *(GAS u32x2*)((unsigned char*)YB + ((size_t)(u.pm * 256 + ai * 128 + wr * 64 + m * 16 + fr) * D + c0 + bj * 128)) = (u32x2){(unsigned)w0, (unsigned)w1}; }
                    else { u32x4 w; w.x = cvt_pk_bf16(v0[0], v0[1]); w.y = cvt_pk_bf16(v0[2], v0[3]); w.z = cvt_pk_bf16(v1[0], v1[1]); w.w = cvt_pk_bf16(v1[2], v1[3]);
                        *(GAS u32x4*)(rowp + bj * 128) = w; } } } }
    }
};
template <bool LAST, bool H8 = false>
__device__ __forceinline__ void combine_phase(Frame& F, bf16* X, const bf16* YB, const int* rec, const float* gates, const float* modl, int nrows, float* out,
                                              const float* gn, const float* modn, bf16* H) {
    volatile LAS unsigned* tb = F.MISC + 64;
    for (int row = F.gw; row < nrows; row += F.NGW) {
        const int isc = row >= SEQ ? 1 : 0;
        const float* g2 = modl + (size_t)isc * 6 * D + (size_t)5 * D;
        int ridx[4]; float gv[4];
#pragma unroll
        for (int k = 0; k < 4; ++k) { const int e = rec[(row * 4 + k) * 2], pos = rec[(row * 4 + k) * 2 + 1]; ridx[k] = 256 * (int)tb[e] + pos; gv[k] = gates[row * 4 + k]; }
        u32x4 yb[4][4]; f32x4 v[8], gg[8];
#pragma unroll
        for (int j = 0; j < 4; ++j) { const int c = 8 * (F.lane + 64 * j);
#pragma unroll
            for (int k = 0; k < 4; ++k) { if constexpr (MOE_FP8) { const u32x2 q8 = __builtin_nontemporal_load((const GAS u32x2*)((const unsigned char*)YB + (size_t)ridx[k] * D + c)); yb[j][k] = (u32x4){q8.x, q8.y, 0u, 0u}; } else yb[j][k] = *(const GAS u32x4*)(YB + (size_t)ridx[k] * D + c); }
            { const u32x4 w = *(const GAS u32x4*)(X + (size_t)row * D + c); v[2 * j] = (f32x4){bflo(w.x), bfhi(w.x), bflo(w.y), bfhi(w.y)}; v[2 * j + 1] = (f32x4){bflo(w.z), bfhi(w.z), bflo(w.w), bfhi(w.w)}; }
            gg[2 * j] = *(const GAS f32x4*)(g2 + c); gg[2 * j + 1] = *(const GAS f32x4*)(g2 + c + 4); }
#pragma unroll
        for (int j = 0; j < 4; ++j) {
            f32x4 s0 = (f32x4){0.f, 0.f, 0.f, 0.f}, s1 = (f32x4){0.f, 0.f, 0.f, 0.f};
#pragma unroll
            for (int k = 0; k < 4; ++k) { const u32x4 w = yb[j][k];
                if constexpr (MOE_FP8) { const f32x2 a0 = __builtin_amdgcn_cvt_pk_f32_fp8((int)w.x, false), a1 = __builtin_amdgcn_cvt_pk_f32_fp8((int)w.x, true), a2 = __builtin_amdgcn_cvt_pk_f32_fp8((int)w.y, false), a3 = __builtin_amdgcn_cvt_pk_f32_fp8((int)w.y, true);
                    s0 += gv[k] * (f32x4){a0.x, a0.y, a1.x, a1.y}; s1 += gv[k] * (f32x4){a2.x, a2.y, a3.x, a3.y}; }
                else { s0 += gv[k] * (f32x4){bflo(w.x), bfhi(w.x), bflo(w.y), bfhi(w.y)}; s1 += gv[k] * (f32x4){bflo(w.z), bfhi(w.z), bflo(w.w), bfhi(w.w)}; } }
            v[2 * j] = v[2 * j] + gg[2 * j] * s0; v[2 * j + 1] = v[2 * j + 1] + gg[2 * j + 1] * s1;
        }
        if (!LAST) {
            const float* m = modn + (size_t)isc * 6 * D;
            f32x4 sh[8], sc[8];
#pragma unroll
            for (int j = 0; j < 4; ++j) { const int c = 8 * (F.lane + 64 * j);
                gg[2 * j] = *(const GAS f32x4*)(gn + c); gg[2 * j + 1] = *(const GAS f32x4*)(gn + c + 4); sh[2 * j] = *(const GAS f32x4*)(m + c); sh[2 * j + 1] = *(const GAS f32x4*)(m + c + 4);
                sc[2 * j] = *(const GAS f32x4*)(m + D + c); sc[2 * j + 1] = *(const GAS f32x4*)(m + D + c + 4); }
            float s = 0.f;
#pragma unroll
            for (int j = 0; j < 8; ++j) s += (v[j].x * v[j].x + v[j].y * v[j].y) + (v[j].z * v[j].z + v[j].w * v[j].w);
            const float r = rsqrtf(wave_sum(s) * (1.f / D) + 1e-6f);
#pragma unroll
            for (int j = 0; j < 4; ++j) { const int c = 8 * (F.lane + 64 * j);
                { u32x4 w; w.x = cvt_pk_bf16(v[2 * j].x, v[2 * j].y); w.y = cvt_pk_bf16(v[2 * j].z, v[2 * j].w); w.z = cvt_pk_bf16(v[2 * j + 1].x, v[2 * j + 1].y); w.w = cvt_pk_bf16(v[2 * j + 1].z, v[2 * j + 1].w); *(GAS u32x4*)(X + (size_t)row * D + c) = w; }
                const f32x4 y0 = v[2 * j] * r * gg[2 * j] * (sc[2 * j] + 1.f) + sh[2 * j], y1 = v[2 * j + 1] * r * gg[2 * j + 1] * (sc[2 * j + 1] + 1.f) + sh[2 * j + 1];
                if constexpr (H8) { int w0 = __builtin_amdgcn_cvt_pk_fp8_f32(y0.x, y0.y, 0, false); w0 = __builtin_amdgcn_cvt_pk_fp8_f32(y0.z, y0.w, w0, true); int w1 = __builtin_amdgcn_cvt_pk_fp8_f32(y1.x, y1.y, 0, false); w1 = __builtin_amdgcn_cvt_pk_fp8_f32(y1.z, y1.w, w1, true);
                    *(GAS u32x2*)((unsigned char*)H + (size_t)row * D + c) = (u32x2){(unsigned)w0, (unsigned)w1}; }
                else { u32x4 w; w.x = cvt_pk_bf16(y0.x, y0.y); w.y = cvt_pk_bf16(y0.z, y0.w); w.z = cvt_pk_bf16(y1.x, y1.y); w.w = cvt_pk_bf16(y1.z, y1.w);
                    *(GAS u32x4*)(H + (size_t)row * D + c) = w; } }
        } else {
#pragma unroll
            for (int j = 0; j < 4; ++j) { const int c = 8 * (F.lane + 64 * j);
                *(GAS f32x4*)(out + (size_t)row * D + c) = v[2 * j]; *(GAS f32x4*)(out + (size_t)row * D + c + 4) = v[2 * j + 1]; }
        }
    }
}
}
namespace mk {
struct EpiConvIn {
    static constexpr bool PERM = true;
    bf16* GB; bf16* S; float sc;
    __device__ __forceinline__ void operator()(const AccT& acc, const Unit& u, int wr, int wc, int fr, int fq) const {
        const int j0 = wc * 32 + 8 * fq;
#pragma unroll
        for (int ai = 0; ai < 2; ++ai)
#pragma unroll
            for (int m = 0; m < 4; ++m) { const size_t row = (size_t)u.pm * 256 + ai * 128 + wr * 64 + m * 16 + fr;
                if (u.pn < 8) {
#pragma unroll
                    for (int bj = 0; bj < 2; ++bj) { const f32x4 v0 = acc[ai][bj][m][0] * sc, v1 = acc[ai][bj][m][1] * sc;
                        u32x4 w; w.x = cvt_pk_bf16(v0[0], v0[1]); w.y = cvt_pk_bf16(v0[2], v0[3]); w.z = cvt_pk_bf16(v1[0], v1[1]); w.w = cvt_pk_bf16(v1[2], v1[3]);
                        *(GAS u32x4*)(GB + row * D + u.pn * 256 + bj * 128 + j0) = w; }
                } else {
                    const f32x4 v0 = acc[ai][0][m][0] * acc[ai][1][m][0] * (sc * sc), v1 = acc[ai][0][m][1] * acc[ai][1][m][1] * (sc * sc);
                    u32x4 w; w.x = cvt_pk_bf16(v0[0], v0[1]); w.y = cvt_pk_bf16(v0[2], v0[3]); w.z = cvt_pk_bf16(v1[0], v1[1]); w.w = cvt_pk_bf16(v1[2], v1[3]);
                    *(GAS u32x4*)(S + row * D + (u.pn - 8) * 128 + j0) = w;
                } }
    }
};
__device__ __forceinline__ void conv_phase(Frame& F, const bf16* GB, const bf16* S, const float* ck, const float* cb, bf16* A2) {
    const int gt = F.gw * 64 + F.lane, c8 = (gt & 255) * 8, r0 = gt >> 8, rstep = (F.NGW * 64) >> 8;
    float kk[3][8], bb[8];
#pragma unroll
    for (int w = 0; w < 3; ++w) { const f32x4 a = *(const GAS f32x4*)(ck + w * D + c8), b = *(const GAS f32x4*)(ck + w * D + c8 + 4); kk[w][0] = a.x; kk[w][1] = a.y; kk[w][2] = a.z; kk[w][3] = a.w; kk[w][4] = b.x; kk[w][5] = b.y; kk[w][6] = b.z; kk[w][7] = b.w; }
    { const f32x4 a = *(const GAS f32x4*)(cb + c8), b = *(const GAS f32x4*)(cb + c8 + 4); bb[0] = a.x; bb[1] = a.y; bb[2] = a.z; bb[3] = a.w; bb[4] = b.x; bb[5] = b.y; bb[6] = b.z; bb[7] = b.w; }
    for (int t0 = r0; t0 < T; t0 += 4 * rstep) {
        u32x4 sv[4][3], gv[4];
#pragma unroll
        for (int i = 0; i < 4; ++i) { const int t = t0 + i * rstep; const int tc = t < T ? t : T - 1; const int lo = tc < SEQ ? 0 : SEQ, hi = tc < SEQ ? SEQ : T;
#pragma unroll
            for (int w = 0; w < 3; ++w) { const int tt = tc + w - 1; const int tl = tt < lo ? lo : (tt >= hi ? hi - 1 : tt); sv[i][w] = *(const GAS u32x4*)(S + (size_t)tl * D + c8); }
            gv[i] = __builtin_nontemporal_load((const GAS u32x4*)(GB + (size_t)tc * D + c8)); }
#pragma unroll
        for (int i = 0; i < 4; ++i) { const int t = t0 + i * rstep; if (t >= T) break; const int lo = t < SEQ ? 0 : SEQ, hi = t < SEQ ? SEQ : T;
            float z[8];
#pragma unroll
            for (int e = 0; e < 8; ++e) z[e] = bb[e];
#pragma unroll
            for (int w = 0; w < 3; ++w) { const int tt = t + w - 1; const float on = (tt >= lo && tt < hi) ? 1.f : 0.f; const u32x4 x = sv[i][w];
                z[0] += on * kk[w][0] * bflo(x.x); z[1] += on * kk[w][1] * bfhi(x.x); z[2] += on * kk[w][2] * bflo(x.y); z[3] += on * kk[w][3] * bfhi(x.y);
                z[4] += on * kk[w][4] * bflo(x.z); z[5] += on * kk[w][5] * bfhi(x.z); z[6] += on * kk[w][6] * bflo(x.w); z[7] += on * kk[w][7] * bfhi(x.w); }
            const u32x4 gq = gv[i];
            u32x4 o; o.x = cvt_pk_bf16(z[0] * bflo(gq.x), z[1] * bfhi(gq.x)); o.y = cvt_pk_bf16(z[2] * bflo(gq.y), z[3] * bfhi(gq.y));
            o.z = cvt_pk_bf16(z[4] * bflo(gq.z), z[5] * bfhi(gq.z)); o.w = cvt_pk_bf16(z[6] * bflo(gq.w), z[7] * bfhi(gq.w));
            *(GAS u32x4*)(A2 + (size_t)t * D + c8) = o; }
    }
}
struct EpiQKV {
    static constexpr bool PERM = true;
    bf16* QR; bf16* KR; bf16* VR; float sc;
    __device__ __forceinline__ void operator()(const AccT& acc, const Unit& u, int wr, int wc, int fr, int fq) const {
        bf16* base; int ld, c0;
        if (u.pn < 8) { base = QR; ld = 2048; c0 = u.pn * 256; } else if (u.pn < 10) { base = KR; ld = 512; c0 = (u.pn - 8) * 256; } else { base = VR; ld = 512; c0 = (u.pn - 10) * 256; }
        c0 += wc * 32 + 8 * fq;
#pragma unroll
        for (int ai = 0; ai < 2; ++ai)
#pragma unroll
            for (int m = 0; m < 4; ++m) { bf16* rowp = base + ((size_t)u.pm * 256 + ai * 128 + wr * 64 + m * 16 + fr) * ld + c0;
#pragma unroll
                for (int bj = 0; bj < 2; ++bj) { const f32x4 v0 = acc[ai][bj][m][0] * sc, v1 = acc[ai][bj][m][1] * sc;
                    u32x4 w; w.x = cvt_pk_bf16(v0[0], v0[1]); w.y = cvt_pk_bf16(v0[2], v0[3]); w.z = cvt_pk_bf16(v1[0], v1[1]); w.w = cvt_pk_bf16(v1[2], v1[3]);
                    *(GAS u32x4*)(rowp + bj * 128) = w; } }
    }
};
__device__ __forceinline__ void qkv_prep_phase(Frame& F, const bf16* QR, const bf16* KR, const bf16* VR, const float* qg, const float* kg, bf16* QB, bf16* KB, bf16* VB, unsigned char* V8T) {
    const int sub = F.lane >> 4, l16 = F.lane & 15, e0 = l16 * 8;
    float inv[8];
#pragma unroll
    for (int e = 0; e < 8; ++e) inv[e] = __expf(-(float)((e0 + e) & 31) * (9.210340371976184f / 32.f));
    float gq[8], gk[8];
#pragma unroll
    for (int e = 0; e < 8; ++e) { gq[e] = qg[e0 + e] * (ATT_PV8 ? att::QK_FOLD : 1.f); gk[e] = kg[e0 + e] * (ATT_PV8 ? att::QK_FOLD : 1.f); }
    const int ngrp = ATT_PV8 ? 5 : 6;
    for (int w0 = F.gw; w0 < T * ngrp; w0 += 2 * F.NGW) {
        u32x4 xin[2];
#pragma unroll
        for (int i = 0; i < 2; ++i) { int w = w0 + i * F.NGW; if (w >= T * ngrp) w = T * ngrp - 1; const int row = w / ngrp, slot = (w % ngrp) * 4 + sub;
            const bf16* src = slot < 16 ? QR + (size_t)row * 2048 + slot * 128 : slot < 20 ? KR + (size_t)row * 512 + (slot - 16) * 128 : VR + (size_t)row * 512 + (slot - 20) * 128;
            xin[i] = __builtin_nontemporal_load((const GAS u32x4*)(src + e0)); }
#pragma unroll
        for (int i = 0; i < 2; ++i) { const int w = w0 + i * F.NGW; if (w >= T * ngrp) break; const int row = w / ngrp, slot = (w % ngrp) * 4 + sub;
            bf16* dst = slot < 16 ? QB + (size_t)row * 2048 + slot * 128 : slot < 20 ? KB + (size_t)row * 512 + (slot - 16) * 128 : VB + (size_t)row * 512 + (slot - 20) * 128;
            float x[8] = {bflo(xin[i].x), bfhi(xin[i].x), bflo(xin[i].y), bfhi(xin[i].y), bflo(xin[i].z), bfhi(xin[i].z), bflo(xin[i].w), bfhi(xin[i].w)};
            if (slot < 20) {
                float s = 0.f;
#pragma unroll
                for (int e = 0; e < 8; ++e) s += x[e] * x[e];
                s += dpp_get<0xB1>(s); s += dpp_get<0x4E>(s); s += dpp_get<0x124>(s); s += dpp_get<0x128>(s);
                const float r = rsqrtf(s * (1.f / 128.f) + 1e-6f);
#pragma unroll
                for (int e = 0; e < 8; ++e) x[e] = x[e] * r * (slot < 16 ? gq[e] : gk[e]);
                if (row < SEQ) {
                    const float pos = (l16 & 4) ? (float)(row & 63) : (float)(row >> 6);
#pragma unroll
                    for (int e = 0; e < 8; ++e) { const float other = dpp_get<0x128>(x[e]);        float sn, cs; __sincosf(pos * inv[e], &sn, &cs);
                        x[e] = (l16 & 8) ? (x[e] * cs + other * sn) : (x[e] * cs - other * sn); }
                }
            }
            if (ATT_FP8 && slot < 20) {
                unsigned char* d8 = slot < 16 ? (unsigned char*)QB + (size_t)row * 2048 + slot * 128 : (unsigned char*)KB + (size_t)row * 512 + (slot - 16) * 128;
                int w0 = __builtin_amdgcn_cvt_pk_fp8_f32(x[0], x[1], 0, false); w0 = __builtin_amdgcn_cvt_pk_fp8_f32(x[2], x[3], w0, true); int w1 = __builtin_amdgcn_cvt_pk_fp8_f32(x[4], x[5], 0, false); w1 = __builtin_amdgcn_cvt_pk_fp8_f32(x[6], x[7], w1, true);
                *(GAS u32x2*)(d8 + e0) = (u32x2){(unsigned)w0, (unsigned)w1};
            } else { u32x4 o; o.x = cvt_pk_bf16(x[0], x[1]); o.y = cvt_pk_bf16(x[2], x[3]); o.z = cvt_pk_bf16(x[4], x[5]); o.w = cvt_pk_bf16(x[6], x[7]);
                *(GAS u32x4*)(dst + e0) = o; } }
    }
    if constexpr (ATT_PV8) {
        __syncthreads();
        LAS unsigned char* scr = (LAS unsigned char*)(F.lds + F.wave * 8192);
        const int key = F.lane, b32 = key >> 5, k5 = key & 31, khi = (k5 >> 2) & 1, rr = (k5 & 3) + 4 * (k5 >> 3), rho = khi * 32 + rr + 16 * b32;
        for (int it = F.gw; it < 4 * (T / 64); it += F.NGW) {
            const int kvh = it / (T / 64), tile = it % (T / 64);
            const bf16* src = VR + (size_t)(tile * 64 + key) * 512 + kvh * 128;
            u32x4 v[16];
#pragma unroll
            for (int c = 0; c < 16; ++c) v[c] = *(const GAS u32x4*)(src + 8 * c);
#pragma unroll
            for (int c = 0; c < 16; ++c) { const unsigned w4[4] = {v[c].x, v[c].y, v[c].z, v[c].w};
#pragma unroll
                for (int q = 0; q < 4; ++q) { const int pk = __builtin_amdgcn_cvt_pk_fp8_f32(bflo(w4[q]), bfhi(w4[q]), 0, false); const int d = 8 * c + 2 * q;
                    scr[d * 64 + rho] = (unsigned char)(pk & 0xff); scr[(d + 1) * 64 + rho] = (unsigned char)((pk >> 8) & 0xff); } }
            asm volatile("s_waitcnt lgkmcnt(0)" ::: "memory");
            unsigned char* dst = V8T + ((size_t)kvh * (T / 64) + tile) * 8192;
#pragma unroll
            for (int i = 0; i < 8; ++i) { const u32x4 o = *(const LAS u32x4*)(scr + (F.lane + 64 * i) * 16); *(GAS u32x4*)(dst + (F.lane + 64 * i) * 16) = o; }
            asm volatile("s_waitcnt lgkmcnt(0)" ::: "memory");
        }
    }
}

__device__ __forceinline__ void attn_phase(Frame& F, const bf16* QB, const bf16* KB, const bf16* VB, bf16* O, const unsigned char* V8T) {
    for (int i = 0;; ++i) {
        const int u = i * F.G + F.vcu; if (u >= 1040) break;
        int h, qb, seq; long krow0;
        if (u < 1024) { h = u >> 6; qb = u & 63; seq = T; krow0 = 0; } else { h = u - 1024; qb = 64; seq = CTX; krow0 = SEQ; }
        const int kvh = h >> 2; const long qrow0 = (long)qb * 256;
        if constexpr (ATT_PV8) att::attn_dense_body_f8pv<att::bf16>((const unsigned char*)QB + qrow0 * 2048 + h * 128, (const unsigned char*)KB + krow0 * 512 + kvh * 128, V8T + ((size_t)kvh * (T / 64) + krow0 / 64) * 8192,
                                                   (att::bf16*)O + qrow0 * 2048 + h * 128, seq, (char*)F.lds);
        else if constexpr (ATT_FP8) att::attn_dense_body_f8<att::bf16>((const unsigned char*)QB + qrow0 * 2048 + h * 128, (const unsigned char*)KB + krow0 * 512 + kvh * 128, (const att::bf16*)VB + krow0 * 512 + kvh * 128,
                                                   (att::bf16*)O + qrow0 * 2048 + h * 128, seq, (char*)F.lds);
        else att::attn_dense_body<att::bf16, att::bf16>((const att::bf16*)QB + qrow0 * 2048 + h * 128, (const att::bf16*)KB + krow0 * 512 + kvh * 128, (const att::bf16*)VB + krow0 * 512 + kvh * 128,
                                                   (att::bf16*)O + qrow0 * 2048 + h * 128, seq, (char*)F.lds);
        __syncthreads();
    }
}
__device__ __forceinline__ void ssm_z_phase(Frame& F, const bf16* H, const float* dskip, const bf16* Yd, bf16* Z) {
    const size_t n = (size_t)SEQ * D;
    const int gt = F.gw * 64 + F.lane, c8 = (gt & 255) * 8, r0 = gt >> 8, rstep = (F.NGW * 64) >> 8;
    const f32x4 d0 = *(const GAS f32x4*)(dskip + c8), d1 = *(const GAS f32x4*)(dskip + c8 + 4);
    for (int t0 = r0; t0 < SEQ; t0 += 4 * rstep) {
        u32x4 hv[4], ya[4], yb[4];
#pragma unroll
        for (int i = 0; i < 4; ++i) { const int t = t0 + i * rstep; const size_t e0 = (size_t)(t < SEQ ? t : SEQ - 1) * D + c8;
            hv[i] = *(const GAS u32x4*)(H + e0); ya[i] = __builtin_nontemporal_load((const GAS u32x4*)(Yd + e0)); yb[i] = __builtin_nontemporal_load((const GAS u32x4*)(Yd + n + e0)); }
#pragma unroll
        for (int i = 0; i < 4; ++i) { const int t = t0 + i * rstep; if (t >= SEQ) break; const size_t e0 = (size_t)t * D + c8;
            const u32x4 a = ya[i], b = yb[i]; const u32x4 h = hv[i];
            const f32x4 y0 = (f32x4){bflo(a.x) + bflo(b.x), bfhi(a.x) + bfhi(b.x), bflo(a.y) + bflo(b.y), bfhi(a.y) + bfhi(b.y)}, y1 = (f32x4){bflo(a.z) + bflo(b.z), bfhi(a.z) + bfhi(b.z), bflo(a.w) + bflo(b.w), bfhi(a.w) + bfhi(b.w)};
            float z[8] = {d0.x * bflo(h.x) + y0.x, d0.y * bfhi(h.x) + y0.y, d0.z * bflo(h.y) + y0.z, d0.w * bfhi(h.y) + y0.w,
                          d1.x * bflo(h.z) + y1.x, d1.y * bfhi(h.z) + y1.y, d1.z * bflo(h.w) + y1.z, d1.w * bfhi(h.w) + y1.w};
#pragma unroll
            for (int e = 0; e < 8; ++e) z[e] = gelu_tanh_f(z[e]);
            if constexpr (GLU_FP8) { int w0 = __builtin_amdgcn_cvt_pk_fp8_f32(z[0], z[1], 0, false); w0 = __builtin_amdgcn_cvt_pk_fp8_f32(z[2], z[3], w0, true); int w1 = __builtin_amdgcn_cvt_pk_fp8_f32(z[4], z[5], 0, false); w1 = __builtin_amdgcn_cvt_pk_fp8_f32(z[6], z[7], w1, true);
                *(GAS u32x2*)((unsigned char*)Z + e0) = (u32x2){(unsigned)w0, (unsigned)w1}; }
            else { u32x4 o; o.x = cvt_pk_bf16(z[0], z[1]); o.y = cvt_pk_bf16(z[2], z[3]); o.z = cvt_pk_bf16(z[4], z[5]); o.w = cvt_pk_bf16(z[6], z[7]);
                *(GAS u32x4*)(Z + e0) = o; } }
    }
}
struct EpiGlu {
    static constexpr bool PERM = true;
    bf16* X; const float* glu_b; const float* g1; float sc;
    __device__ __forceinline__ void operator()(const AccT& acc, const Unit& u, int wr, int wc, int fr, int fq) const {
        const int col0 = u.pn * 128 + wc * 32 + 8 * fq;
        f32x4 ba[2], bg[2], gv[2];
#pragma unroll
        for (int n = 0; n < 2; ++n) { ba[n] = *(const GAS f32x4*)(glu_b + col0 + n * 4); bg[n] = *(const GAS f32x4*)(glu_b + D + col0 + n * 4); gv[n] = *(const GAS f32x4*)(g1 + col0 + n * 4); }
#pragma unroll
        for (int ai = 0; ai < 2; ++ai)
#pragma unroll
            for (int m = 0; m < 4; ++m) { bf16* rowp = X + ((size_t)u.pm * 256 + ai * 128 + wr * 64 + m * 16 + fr) * D + col0;
                const u32x4 w = *(const GAS u32x4*)rowp; f32x4 r[2] = {(f32x4){bflo(w.x), bfhi(w.x), bflo(w.y), bfhi(w.y)}, (f32x4){bflo(w.z), bfhi(w.z), bflo(w.w), bfhi(w.w)}};
#pragma unroll
                for (int n = 0; n < 2; ++n) { const f32x4 av = acc[ai][0][m][n] * sc + ba[n], gg = acc[ai][1][m][n] * sc + bg[n];
                    f32x4 sg; sg.x = sigm_f(gg.x); sg.y = sigm_f(gg.y); sg.z = sigm_f(gg.z); sg.w = sigm_f(gg.w);
                    r[n] = r[n] + gv[n] * av * sg; }
                u32x4 o; o.x = cvt_pk_bf16(r[0].x, r[0].y); o.y = cvt_pk_bf16(r[0].z, r[0].w); o.z = cvt_pk_bf16(r[1].x, r[1].y); o.w = cvt_pk_bf16(r[1].z, r[1].w);
                *(GAS u32x4*)rowp = o; }
    }
};
}
namespace mk {
constexpr int SSM_RA = 0, SSM_BST_LD = 528, SSM_CST_LD = 272, SSM_KM = 69632, SSM_TBL = 78336, SSM_TE = 90624;
__device__ __forceinline__ f32x2 cmul(f32x2 a, f32x2 b) { return (f32x2){a.x * b.x - a.y * b.y, a.x * b.y + a.y * b.x}; }
__device__ __forceinline__ float dpp_shr(float v, int o) {
    const int x = __builtin_bit_cast(int, v); int r;
    if (o == 1) r = __builtin_amdgcn_update_dpp(0, x, 0x111, 0xf, 0xf, true); else if (o == 2) r = __builtin_amdgcn_update_dpp(0, x, 0x112, 0xf, 0xf, true);
    else if (o == 4) r = __builtin_amdgcn_update_dpp(0, x, 0x114, 0xf, 0xf, true); else r = __builtin_amdgcn_update_dpp(0, x, 0x118, 0xf, 0xf, true);
    return __builtin_bit_cast(float, r);
}
__device__ __forceinline__ int ssm_row(int s, int d) {
    if (s < CTX) return SEQ + (d ? CTX - 1 - s : s);
    const int li = s - CTX; return d ? SEQ - 1 - li : li;
}
template <int XS = 0>
__device__ __forceinline__ void ssm_mfma_phase(Frame& F, const bf16* H, const float* a_re, const float* a_im, const float* log_dt,
                                               const float* b_re, const float* b_im, const float* c_re, const float* c_im, bf16* Yd, float* SS) {
    LAS unsigned char* lds = F.lds;
    LAS f32x2* TBL = (LAS f32x2*)(lds + SSM_TBL);
    LAS float* TE = (LAS float*)(lds + SSM_TE);
    const int tid = F.tid, lane = F.lane, wave = F.wave, p = tid & 63, l15 = lane & 15, q = lane >> 4;
    for (int dg = F.vcu; dg < 256; dg += F.G) {
        const int d = dg >> 7, g = dg & 127;
        const int gp = dg * 64 + p;
        const float dt = __expf(log_dt[dg]);
        const float are = a_re[gp], aim = a_im[gp];
        f32x2 ab; { const float mag = __expf(are * dt); float sn, cs; sincosf(aim * dt, &sn, &cs); ab = (f32x2){mag * cs, mag * sn}; }
        f32x2 ff; { const float nr = ab.x - 1.f, ni = ab.y, den = are * are + aim * aim; ff = (f32x2){(nr * are + ni * aim) / den, (ni * are - nr * aim) / den}; }
        __syncthreads();
        if (wave == 0) {
            TBL[0 * 64 + p] = ab; TBL[1 * 64 + p] = ff;
            const f32x2 a2 = cmul(ab, ab), a4 = cmul(a2, a2), a8 = cmul(a4, a4), a16 = cmul(a8, a8), a32 = cmul(a16, a16), a64 = cmul(a32, a32), a128 = cmul(a64, a64), a256 = cmul(a128, a128);
            TBL[2 * 64 + p] = a8; TBL[3 * 64 + p] = a16; TBL[4 * 64 + p] = a32; TBL[5 * 64 + p] = a64; TBL[6 * 64 + p] = a128; TBL[7 * 64 + p] = a256;
            f32x2 t = (f32x2){1.f, 0.f};
#pragma unroll 1
            for (int j = 0; j < 16; ++j) { TBL[(8 + j) * 64 + p] = t; t = cmul(t, a16); }
        }
        __syncthreads();
        {
            const int sgrp = tid >> 6;
            f32x2 bbv[16];
#pragma unroll
            for (int c4 = 0; c4 < 4; ++c4) { const f32x4 br = *(const GAS f32x4*)(b_re + (size_t)gp * 16 + 4 * c4), bi = *(const GAS f32x4*)(b_im + (size_t)gp * 16 + 4 * c4);
                bbv[4 * c4 + 0] = cmul(ff, (f32x2){br.x, bi.x}); bbv[4 * c4 + 1] = cmul(ff, (f32x2){br.y, bi.y}); bbv[4 * c4 + 2] = cmul(ff, (f32x2){br.z, bi.z}); bbv[4 * c4 + 3] = cmul(ff, (f32x2){br.w, bi.w}); }
#pragma unroll
            for (int h = 0; h < 2; ++h) { const int sg = 2 * sgrp + h; f32x2 pw = (f32x2){1.f, 0.f};
#pragma unroll 1
                for (int i = 0; i < 15 - sg; ++i) pw = cmul(pw, ab);
                LAS bf16* r0 = (LAS bf16*)(lds + SSM_RA + (2 * p) * SSM_BST_LD) + sg * 16; LAS bf16* r1 = (LAS bf16*)(lds + SSM_RA + (2 * p + 1) * SSM_BST_LD) + sg * 16;
#pragma unroll
                for (int c = 0; c < 16; ++c) { const f32x2 v = cmul(pw, bbv[c]); r0[c] = (bf16)(cvt_pk_bf16(v.x, 0.f) & 0xffffu); r1[c] = (bf16)(cvt_pk_bf16(v.y, 0.f) & 0xffffu); } }
            const int pair = tid & 255, half = tid >> 8, cp = pair >> 4, cc = pair & 15;
            float accl[8] = {0.f, 0.f, 0.f, 0.f, 0.f, 0.f, 0.f, 0.f};
#pragma unroll 1
            for (int p0 = 0; p0 < 64; p0 += 8) {
                f32x2 cv[8], bv[8];
#pragma unroll
                for (int i8 = 0; i8 < 8; ++i8) { const int pp = p0 + i8; const size_t ci = ((size_t)dg * 16 + cp) * 64 + pp, bi_ = ((size_t)dg * 64 + pp) * 16 + cc;
                    cv[i8] = (f32x2){c_re[ci], c_im[ci]}; bv[i8] = (f32x2){b_re[bi_], b_im[bi_]}; }
#pragma unroll
                for (int i8 = 0; i8 < 8; ++i8) { const int pp = p0 + i8;
                    const f32x2 ap = TBL[pp], fp = TBL[64 + pp], a8p = TBL[128 + pp];
                    f32x2 t = cmul(cv[i8], cmul(fp, bv[i8]));
                    if (half) t = cmul(t, a8p);
#pragma unroll
                    for (int i = 0; i < 8; ++i) { accl[i] += t.x; t = cmul(t, ap); } }
            }
            LAS bf16* km = (LAS bf16*)(lds + SSM_KM);
#pragma unroll
            for (int i = 0; i < 8; ++i) km[(8 * half + i + 1) * 256 + pair] = (bf16)(cvt_pk_bf16(accl[i], 0.f) & 0xffffu);
            if (tid < 256) km[tid] = 0;
        }
        __syncthreads();
        for (int ct = (XS & 1) ? 65 : wave; ct < 65; ct += 8) {
            bf16x8 uf[8];
#pragma unroll
            for (int ks = 0; ks < 8; ++ks) { const int s = (ct * 16 + l15) * 16 + 2 * ks + (q >> 1); uf[ks] = *(const GAS bf16x8*)(H + (size_t)ssm_row(s, d) * D + g * 16 + 8 * (q & 1)); }
            f32x4 acc[8];
#pragma unroll
            for (int mt = 0; mt < 8; ++mt) { acc[mt] = (f32x4){0.f, 0.f, 0.f, 0.f};
#pragma unroll
                for (int ks = 0; ks < 8; ++ks) { const bf16x8 af = *(const LAS bf16x8*)(lds + SSM_RA + (16 * mt + l15) * SSM_BST_LD + (32 * ks + 8 * q) * 2);
                    acc[mt] = __builtin_amdgcn_mfma_f32_16x16x32_bf16(af, uf[ks], acc[mt], 0, 0, 0); } }
#pragma unroll
            for (int oi = 0; oi < 4; ++oi) {
#pragma unroll
                for (int mt = 0; mt < 8; ++mt) { const f32x4 pw = *(const LAS f32x4*)(TBL + (3 + oi) * 64 + 8 * mt + 2 * q);
                    const float t0 = dpp_shr(acc[mt].x, 1 << oi), t1 = dpp_shr(acc[mt].y, 1 << oi), t2 = dpp_shr(acc[mt].z, 1 << oi), t3 = dpp_shr(acc[mt].w, 1 << oi);
                    acc[mt].x += pw.x * t0 - pw.y * t1; acc[mt].y += pw.x * t1 + pw.y * t0; acc[mt].z += pw.z * t2 - pw.w * t3; acc[mt].w += pw.z * t3 + pw.w * t2; }
            }
            float* ss = SS + (((size_t)dg * 65 + ct) * 8) * 256 + l15 * 16 + 4 * q;
#pragma unroll
            for (int mt = 0; mt < 8; ++mt) { *(GAS f32x4*)(ss + 256 * mt) = acc[mt]; if (l15 == 15) *(LAS f32x4*)(TE + ct * 128 + 16 * mt + 4 * q) = acc[mt]; }
        }
        asm volatile("s_waitcnt vmcnt(0)" ::: "memory");
        __syncthreads();
        {
            const int tgrp = tid >> 6;
#pragma unroll
            for (int h = 0; h < 2; ++h) { const int tau = 2 * tgrp + h; f32x2 pw = ab;
#pragma unroll 1
                for (int i = 0; i < tau; ++i) pw = cmul(pw, ab);
                f32x2 cvv[16];
#pragma unroll
                for (int c = 0; c < 16; ++c) { const size_t ci = ((size_t)dg * 16 + c) * 64 + p; cvv[c] = (f32x2){c_re[ci], c_im[ci]}; }
#pragma unroll
                for (int c = 0; c < 16; ++c) { const f32x2 v = cmul(cvv[c], pw);
                    *(LAS unsigned*)(lds + SSM_RA + (tau * 16 + c) * SSM_CST_LD + (2 * p) * 2) = cvt_pk_bf16(v.x, -v.y); } }
        }
        if (wave == 0) {
            const f32x2 a256 = TBL[7 * 64 + p]; f32x2 c = (f32x2){0.f, 0.f};
#pragma unroll 1
            for (int ct = 0; ct < 65; ++ct) { LAS f32x2* te = (LAS f32x2*)(TE + ct * 128) + p; const f32x2 e = *te; *te = c; c = cmul(a256, c) + e; }
        }
        __syncthreads();
        const int chl = 4 * (((l15 >> 2) & 1) * 2 + ((l15 >> 3) & 1)) + (l15 & 3);
        const int kbase = SSM_KM + (-(q >> 1) * 256 + chl * 16 + 8 * (q & 1)) * 2, cbase = SSM_RA + chl * SSM_CST_LD + 16 * q;
        bf16* Y = Yd + (size_t)d * SEQ * D;
        for (int ct = (XS & 2) ? 65 : 1 + wave; ct < 65; ct += 8) {
            bf16x8 uf[8];
#pragma unroll
            for (int ks = 0; ks < 8; ++ks) { const int s = (ct * 16 + l15) * 16 + 2 * ks + (q >> 1); uf[ks] = *(const GAS bf16x8*)(H + (size_t)ssm_row(s, d) * D + g * 16 + 8 * (q & 1)); }
            bf16x8 sf[4];
            const float msk = l15 ? 1.f : 0.f;
            const int cprev = ct * 16 + l15 - 1;
            const float* sl = SS + (((size_t)dg * 65 + (cprev >> 4)) * 8) * 256 + (cprev & 15) * 16 + 8 * (q & 1);
#pragma unroll
            for (int ks = 0; ks < 4; ++ks) {
                const int p0 = 16 * ks + 4 * q;
                const f32x4 s0 = __builtin_nontemporal_load((const GAS f32x4*)(sl + (2 * ks + (q >> 1)) * 256)), s1 = __builtin_nontemporal_load((const GAS f32x4*)(sl + (2 * ks + (q >> 1)) * 256 + 4));
                const f32x4 c0 = *(const LAS f32x4*)(TE + ct * 128 + 2 * p0), c1 = *(const LAS f32x4*)(TE + ct * 128 + 2 * p0 + 4);
                const f32x4 w0 = *(const LAS f32x4*)(TBL + (8 + l15) * 64 + p0), w1 = *(const LAS f32x4*)(TBL + (8 + l15) * 64 + p0 + 2);
                const float v0 = w0.x * c0.x - w0.y * c0.y + msk * s0.x, v1 = w0.x * c0.y + w0.y * c0.x + msk * s0.y, v2 = w0.z * c0.z - w0.w * c0.w + msk * s0.z, v3 = w0.z * c0.w + w0.w * c0.z + msk * s0.w;
                const float v4 = w1.x * c1.x - w1.y * c1.y + msk * s1.x, v5 = w1.x * c1.y + w1.y * c1.x + msk * s1.y, v6 = w1.z * c1.z - w1.w * c1.w + msk * s1.z, v7 = w1.z * c1.w + w1.w * c1.z + msk * s1.w;
                u32x4 w; w.x = cvt_pk_bf16(v0, v1); w.y = cvt_pk_bf16(v2, v3); w.z = cvt_pk_bf16(v4, v5); w.w = cvt_pk_bf16(v6, v7); sf[ks] = __builtin_bit_cast(bf16x8, w);
            }
#pragma unroll
            for (int tp = 0; tp < 8; ++tp) {
                unsigned wx[2], wy[2];
#pragma unroll
                for (int h = 0; h < 2; ++h) { const int tau = 2 * tp + h;
                    f32x4 acc = (f32x4){0.f, 0.f, 0.f, 0.f};
#pragma unroll
                    for (int ks = 0; ks <= (tau >> 1); ++ks) { const bf16x8 af = *(const LAS bf16x8*)(lds + kbase + (tau - 2 * ks + 1) * 512); acc = __builtin_amdgcn_mfma_f32_16x16x32_bf16(af, uf[ks], acc, 0, 0, 0); }
#pragma unroll
                    for (int ks = 0; ks < 4; ++ks) { const bf16x8 af = *(const LAS bf16x8*)(lds + cbase + tau * (16 * SSM_CST_LD) + ks * 64); acc = __builtin_amdgcn_mfma_f32_16x16x32_bf16(af, sf[ks], acc, 0, 0, 0); }
                    wx[h] = pg::cvt_pk_c(acc.x, acc.y); wy[h] = pg::cvt_pk_c(acc.z, acc.w); }
                const auto r0 = __builtin_amdgcn_permlane32_swap(wx[0], wx[1], false, false), r1 = __builtin_amdgcn_permlane32_swap(wy[0], wy[1], false, false);
                const int s = (ct * 16 + l15) * 16 + 2 * tp + (q >> 1);
                *(GAS u32x4*)(Y + (size_t)ssm_row(s, d) * D + g * 16 + 8 * (q & 1)) = (u32x4){r0[0], r1[0], r0[1], r1[1]};
            }
        }
    }
}
}
namespace mk {
constexpr int NPH = 32;
enum { PH_PRO = 0, PH_N0 = 1, PH_L0 = 2, PH_M0 = 6, PH_L1 = 10, PH_M1 = 13, PH_L2 = 17, PH_M2 = 21, PH_L3 = 25, PH_M3 = 28 };

__global__ void __launch_bounds__(NTHR, 2) mk_fwd(Args args) {
    extern __shared__ __attribute__((aligned(16))) unsigned char lds_raw[];
    Frame F;
    F.lds = (LAS unsigned char*)lds_raw; F.MISC = (volatile LAS unsigned*)(F.lds + MISC_OFF);
    F.tid = threadIdx.x; F.lane = F.tid & 63; F.wave = __builtin_amdgcn_readfirstlane(F.tid >> 6);
    F.G = gridDim.x; { const int bx = blockIdx.x; F.vcu = (F.G % 8 == 0) ? (bx % 8) * (F.G / 8) + bx / 8 : bx; }
    F.gw = F.vcu * NWAVES + F.wave; F.NGW = F.G * NWAVES;
    F.ws = args.ws; F.ctl = (unsigned*)(args.ws + WS_CTL); F.ar = args.ws + WS_ARENA;
    for (int u = F.tid; u < (LDS_BYTES - MISC_OFF) / 4; u += NTHR) ((LAS unsigned*)(F.lds + MISC_OFF))[u] = 0u;
    __syncthreads();
    const int lo = args.ph_lo, hi = args.ph_hi;
    XcdBarrier bar; bar.bar = F.ctl + CW_BAR; bar.x = 0; bar.st = nullptr;
    if (hi - lo > 1) bar = xcd_barrier_post(F.ctl + CW_BAR, F.MISC);
#ifdef MK_ONLY
#define IN(k) ((k) == MK_ONLY && lo <= (k) && (k) < hi)
#else
#define IN(k) (lo <= (k) && (k) < hi)
#endif
#define SEAM(k) do { if (IN((k) + 1)) xcd_barrier(bar); } while (0)
    unsigned char* ws = F.ws; unsigned char* ar = F.ar;
    bf16* X = (bf16*)(ws + WS_X); bf16* H = (bf16*)(ws + WS_H); bf16* H2 = (bf16*)(ws + WS_H2);
    const float* MOD = (const float*)(F.ctl + CW_MOD);
    int* REC = (int*)(ws + WS_REC); float* GATE = (float*)(ws + WS_GATE); int* TOKL = (int*)(ws + WS_TOKL);
    bf16* ACT = (bf16*)(ws + WS_ACT); bf16* YB = (bf16*)(ws + WS_YB);
#define GEFF(U) (((U) + (((U) + F.G - 1) / F.G) - 1) / (((U) + F.G - 1) / F.G))
#define BG(lo, hi, geff) do { if (F.vcu >= (geff)) convert_items(F, args, (lo), (hi), (F.vcu - (geff)) * NWAVES + F.wave, (F.G - (geff)) * NWAVES); } while (0)
#define MODL(l) (MOD + (size_t)(l) * 2 * 6 * D)
    const float* XIN_L = args.xin ? args.xin : args.in[0]; const float* XIN_C = args.xin ? args.xin + (size_t)SEQ * D : args.in[2];
#define G1LAT(l) (MODL(l) + 2 * D)
#define G1CTX(l) (MODL(l) + 6 * D + 2 * D)

    if (IN(PH_PRO)) { p0_prologue(F, args); SEAM(PH_PRO); }

#define MOE_BLOCK(l, base, nrows, LASTF, H8F) \
    if (IN((base) + 0)) { router_phase(F, X, args.in[7] + (size_t)(l) * D, MODL(l), args.in[30] + (size_t)(l) * D * NE, args.in[31] + (size_t)(l) * NE, H2, F.ctl + CW_CNT + (l) * 2048, TOKL, REC, GATE, (nrows)); SEAM((base) + 0); } \
    if (IN((base) + 1)) { moe_tables(F, F.ctl + CW_CNT + (l) * 2048); Moe1Prob P; P.init(H2, ws + WS_WT_W1 + (size_t)(l) * NE * 2 * DE * D * MOE_EB, TOKL, F); \
        EpiMoe1 E{ACT, args.in[33] + (size_t)(l) * NE * 2 * DE}; pg::gemm_phase<EpiMoe1, Moe1Prob, true, MOE_FP8>(F.lds, P, E); SEAM((base) + 1); } \
    if (IN((base) + 2)) { moe_tables(F, F.ctl + CW_CNT + (l) * 2048); Moe2Prob P; P.init(ACT, ws + WS_WT_W2 + (size_t)(l) * NE * D * DE * MOE_EB, F); \
        EpiMoe2 E{YB, args.in[35] + (size_t)(l) * NE * D}; pg::gemm_phase<EpiMoe2, Moe2Prob, false, MOE_FP8>(F.lds, P, E); SEAM((base) + 2); } \
    if (IN((base) + 3)) { moe_tables(F, F.ctl + CW_CNT + (l) * 2048); \
        combine_phase<LASTF, H8F>(F, X, YB, REC, GATE, MODL(l), (nrows), args.out, args.in[6] + (size_t)(((l) + 1) & 3) * D, MODL(((l) + 1) & 3), H); SEAM((base) + 3); }

    if (IN(PH_N0)) { norm_phase(F, XIN_L, XIN_C, args.in[6], MODL(0), H, T); SEAM(PH_N0); }
    if (IN(PH_L0 + 0)) {
        { CdftProb P; P.init(ws + WS_DT, H, F); EpiCdft E{(bf16*)(ar + AR_L1)}; pg::gemm_phase<EpiCdft, CdftProb, false>(F.lds, P, E); }
        { CdftCtxProb P; P.init(ws + WS_DT, H, F); EpiCdftCtx E{(bf16*)(ar + AR_LC)}; pg::gemm_phase<EpiCdftCtx, CdftCtxProb, false>(F.lds, P, E); }
        SEAM(PH_L0 + 0); }
    if (IN(PH_L0 + 1)) {
        { Step1Prob P; P.init(ws + WS_DM1, ar + AR_L1, F); EpiStep1 E{(bf16*)(ar + AR_L2)}; pg::gemm_phase<EpiStep1, Step1Prob, false>(F.lds, P, E); }
        { SeqCtxProb P; P.init(ws + WS_DM256, ar + AR_LC, F); EpiSeqCtx E{(bf16*)(ar + AR_F)}; pg::gemm_phase<EpiSeqCtx, SeqCtxProb, false>(F.lds, P, E); }
        SEAM(PH_L0 + 1); }
    if (IN(PH_L0 + 2)) { Step2Prob P; P.init(ws + WS_DM2, ar + AR_L2, F); EpiStep2 E{(bf16*)(ar + AR_F), 1.f / 2048.f}; pg::gemm_phase<EpiStep2, Step2Prob, false>(F.lds, P, E); SEAM(PH_L0 + 2); }
    if (IN(PH_L0 + 3)) { const int ge = GEFF(MT * 8); DenseProb P; P.init(ar + AR_F, ws + WS_WT_F, D, D, D, MT, 8, F, ge); EpiResid<true> E{X, args.in[9], G1LAT(0), G1CTX(0), XIN_L, XIN_C}; pg::gemm_phase<EpiResid<true>, DenseProb, false>(F.lds, P, E);
        BG(tr_moe_lo(0), tr_moe_lo(0) + (TR_NL / 64) * BG_F0, ge); SEAM(PH_L0 + 3); }
    MOE_BLOCK(0, PH_M0, T, false, CIN_FP8)
    if (IN(PH_L1 + 0)) { const int ge = GEFF(MT * 24); constexpr int kd = CIN_FP8 ? D / 2 : D; DenseProbC<kd, MT, 24> P; P.init(H, ws + WS_WT_CIN, F, ge); EpiConvIn E{(bf16*)(ar + AR_GB), (bf16*)(ar + AR_S), CIN_FP8 ? 1.f / D8_WSCALE : 1.f}; pg::gemm_phase<EpiConvIn, DenseProbC<kd, MT, 24>, false, CIN_FP8>(F.lds, P, E);
        BG(tr_moe_lo(1), tr_moe_lo(1) + (TR_NL / 64) * BG_F1A, ge); SEAM(PH_L1 + 0); }
    if (IN(PH_L1 + 1)) { conv_phase(F, (const bf16*)(ar + AR_GB), (const bf16*)(ar + AR_S), args.in[11], args.in[12], (bf16*)(ar + AR_A2)); SEAM(PH_L1 + 1); }
    if (IN(PH_L1 + 2)) { const int ge = GEFF(MT * 8); DenseProb P; P.init(ar + AR_A2, ws + WS_WT_COUT, D, D, D, MT, 8, F, ge); EpiResid<false> E{X, nullptr, G1LAT(1), G1CTX(1), X, X + (size_t)SEQ * D}; pg::gemm_phase<EpiResid<false>, DenseProb, false>(F.lds, P, E);
        BG(tr_moe_lo(1) + (TR_NL / 64) * BG_F1A, tr_moe_lo(1) + (TR_NL / 64) * BG_F1B, ge); SEAM(PH_L1 + 2); }
    MOE_BLOCK(1, PH_M1, T, false, QKV_FP8)
    if (IN(PH_L2 + 0)) { const int ge = GEFF(MT * 12); constexpr int kd = QKV_FP8 ? D / 2 : D; DenseProbC<kd, MT, 12> P; P.init(H, ws + WS_WT_QKV, F, ge); EpiQKV E{(bf16*)(ar + AR_QR), (bf16*)(ar + AR_KR), (bf16*)(ar + AR_VR), QKV_FP8 ? 1.f / D8_WSCALE : 1.f}; pg::gemm_phase<EpiQKV, DenseProbC<kd, MT, 12>, false, QKV_FP8>(F.lds, P, E);
        BG(tr_moe_lo(2), tr_moe_lo(2) + (TR_NL / 64) * BG_F2A, ge); SEAM(PH_L2 + 0); }
    if (IN(PH_L2 + 1)) { qkv_prep_phase(F, (const bf16*)(ar + AR_QR), (const bf16*)(ar + AR_KR), (const bf16*)(ar + AR_VR), args.in[18], args.in[19], (bf16*)(ar + AR_QB), (bf16*)(ar + AR_KB), (bf16*)(ar + AR_VB), ar + AR_V8T); SEAM(PH_L2 + 1); }
    if (IN(PH_L2 + 2)) { attn_phase(F, (const bf16*)(ar + AR_QB), (const bf16*)(ar + AR_KB), (const bf16*)(ar + AR_VB), (bf16*)(ar + AR_O), ar + AR_V8T); SEAM(PH_L2 + 2); }
    if (IN(PH_L2 + 3)) { const int ge = GEFF(MT * 8); DenseProb P; P.init(ar + AR_O, ws + WS_WT_WO, D, D, D, MT, 8, F, ge); EpiResid<false> E{X, nullptr, G1LAT(2), G1CTX(2), X, X + (size_t)SEQ * D}; pg::gemm_phase<EpiResid<false>, DenseProb, false>(F.lds, P, E);
        BG(tr_moe_lo(2) + (TR_NL / 64) * BG_F2A, tr_moe_lo(2) + (TR_NL / 64) * BG_F2B, ge); SEAM(PH_L2 + 3); }
    MOE_BLOCK(2, PH_M2, T, false, false)
    if (IN(PH_L3 + 0)) { ssm_mfma_phase(F, H, args.in[20], args.in[21], args.in[22], args.in[23], args.in[24], args.in[25], args.in[26], (bf16*)(ar + AR_YD), (float*)(ar + AR_SS)); SEAM(PH_L3 + 0); }
    if (IN(PH_L3 + 1)) { ssm_z_phase(F, H, args.in[27], (const bf16*)(ar + AR_YD), (bf16*)(ar + AR_Z)); SEAM(PH_L3 + 1); }
    if (IN(PH_L3 + 2)) { constexpr int kd = GLU_FP8 ? D / 2 : D; DenseProbC<kd, SEQ / 256, 16> P; P.init(ar + AR_Z, ws + WS_WT_GLU, F); EpiGlu E{X, args.in[29], G1LAT(3), GLU_FP8 ? 1.f / D8_WSCALE : 1.f}; pg::gemm_phase<EpiGlu, DenseProbC<kd, SEQ / 256, 16>, false, GLU_FP8>(F.lds, P, E); SEAM(PH_L3 + 2); }
    MOE_BLOCK(3, PH_M3, SEQ, true, false)
#ifdef MK_EXP
    if (IN(51)) { read_items(F, args, tr_moe_lo(3), tr_moe_lo(4), F.gw, F.NGW); }
    if (IN(52)) { convert_items(F, args, tr_moe_lo(3), tr_moe_lo(4), F.gw, F.NGW); }
    if (IN(48)) { ssm_mfma_phase<1>(F, H, args.in[20], args.in[21], args.in[22], args.in[23], args.in[24], args.in[25], args.in[26], (bf16*)(ar + AR_YD), (float*)(ar + AR_SS)); }
    if (IN(49)) { ssm_mfma_phase<2>(F, H, args.in[20], args.in[21], args.in[22], args.in[23], args.in[24], args.in[25], args.in[26], (bf16*)(ar + AR_YD), (float*)(ar + AR_SS)); }
    if (IN(50)) { ssm_mfma_phase<3>(F, H, args.in[20], args.in[21], args.in[22], args.in[23], args.in[24], args.in[25], args.in[26], (bf16*)(ar + AR_YD), (float*)(ar + AR_SS)); }
    if (IN(45)) { router_phase<1>(F, X, args.in[7] + (size_t)3 * D, MODL(3), args.in[30] + (size_t)3 * D * NE, args.in[31] + (size_t)3 * NE, H2, F.ctl + CW_CNT + 3 * 2048, TOKL, REC, GATE, SEQ); }
    if (IN(46)) { router_phase<2>(F, X, args.in[7] + (size_t)3 * D, MODL(3), args.in[30] + (size_t)3 * D * NE, args.in[31] + (size_t)3 * NE, H2, F.ctl + CW_CNT + 3 * 2048, TOKL, REC, GATE, SEQ); }
    if (IN(47)) { router_phase<3>(F, X, args.in[7] + (size_t)3 * D, MODL(3), args.in[30] + (size_t)3 * D * NE, args.in[31] + (size_t)3 * NE, H2, F.ctl + CW_CNT + 3 * 2048, TOKL, REC, GATE, SEQ); }
    if (IN(40)) { moe_tables(F, F.ctl + CW_CNT + 3 * 2048); Moe1ProbHot P; P.init(H2, ws + WS_WT_W1 + (size_t)3 * NE * 2 * DE * D * MOE_EB, TOKL, F);
        EpiMoe1 E{ACT, args.in[33] + (size_t)3 * NE * 2 * DE}; pg::gemm_phase<EpiMoe1, Moe1ProbHot, true, MOE_FP8>(F.lds, P, E); }
    if (IN(41)) { moe_tables(F, F.ctl + CW_CNT + 3 * 2048); Moe1ProbHot P; P.init(H2, ws + WS_WT_W1 + (size_t)3 * NE * 2 * DE * D * MOE_EB, TOKL, F);
        EpiMoe1 E{ACT, args.in[33] + (size_t)3 * NE * 2 * DE}; pg::gemm_phase<EpiMoe1, Moe1ProbHot, true, MOE_FP8, 1>(F.lds, P, E); }
    if (IN(42)) { moe_tables(F, F.ctl + CW_CNT + 3 * 2048); Moe1ProbHot P; P.init(H2, ws + WS_WT_W1 + (size_t)3 * NE * 2 * DE * D * MOE_EB, TOKL, F);
        EpiMoe1 E{ACT, args.in[33] + (size_t)3 * NE * 2 * DE}; pg::gemm_phase<EpiMoe1, Moe1ProbHot, true, MOE_FP8, 3>(F.lds, P, E); }
    if (IN(43)) { moe_tables(F, F.ctl + CW_CNT + 3 * 2048); Moe1ProbHot P; P.init(H2, ws + WS_WT_W1 + (size_t)3 * NE * 2 * DE * D * MOE_EB, TOKL, F);
        EpiMoe1 E{ACT, args.in[33] + (size_t)3 * NE * 2 * DE}; pg::gemm_phase<EpiMoe1, Moe1ProbHot, true, MOE_FP8, 2>(F.lds, P, E); }
    if (IN(44)) { moe_tables(F, F.ctl + CW_CNT + 3 * 2048); Moe1ProbHot P; P.init(H2, ws + WS_WT_W1 + (size_t)3 * NE * 2 * DE * D * MOE_EB, TOKL, F);
        EpiMoe1 E{ACT, args.in[33] + (size_t)3 * NE * 2 * DE}; pg::gemm_phase<EpiMoe1, Moe1ProbHot, true, MOE_FP8, 14>(F.lds, P, E); }
#endif
#undef IN
#undef SEAM
#undef MOE_BLOCK
}

static int fast_grid() { static int g = 0; if (!g) { int dev = 0, cus = 0; if (hipGetDevice(&dev) != hipSuccess || hipDeviceGetAttribute(&cus, hipDeviceAttributeMultiprocessorCount, dev) != hipSuccess || cus <= 0) cus = 256; g = cus < 256 ? (cus >= 88 ? (cus / 8) * 8 : cus) : 256; } return g; }
static void launch_fast(void* const* d_in, float* out, unsigned char* ws, int lo, int hi, hipStream_t st, const float* xin = nullptr) {
    Args a{};
    for (int i = 0; i < 36; ++i) a.in[i] = (const float*)d_in[i];
    a.out = out; a.ws = ws; a.xin = xin; a.ph_lo = lo; a.ph_hi = hi;
    hipLaunchKernelGGL(mk_fwd, dim3(fast_grid()), dim3(NTHR), LDS_BYTES, st, a);
}
static void reset_bar(unsigned char* ws, hipStream_t st) { (void)hipMemsetAsync(ws + WS_CTL + (size_t)CW_BAR * 4, 0, (size_t)XCD_BAR_WORDS * 4, st); }
static int fast_setup() {
    static int ok = 0;
    if (!ok) { if (hipFuncSetAttribute((const void*)mk_fwd, hipFuncAttributeMaxDynamicSharedMemorySize, LDS_BYTES) != hipSuccess) { fprintf(stderr, "hipFuncSetAttribute(mk_fwd) failed\n"); return 0; } ok = 1; }
    return 1;
}
}
extern "C" void kernel_launch(void* const* d_in, const int* in_sizes, int n_in,
                              void* d_out, int out_size, void* d_ws, size_t ws_size,
                              hipStream_t stream) {
    if (!mk::fast_setup()) return;
    if (ws_size < mk::WS_FAST_END) { fprintf(stderr, "kernel_launch: workspace too small (%zu < %zu)\n", ws_size, (size_t)mk::WS_FAST_END); return; }
    (void)hipMemsetAsync((unsigned char*)d_ws + mk::WS_CTL, 0, mk::CTL_BYTES, stream);
    mk::launch_fast(d_in, (float*)d_out, (unsigned char*)d_ws, 0, mk::NPH, stream);
}
```

```cpp
#include <hip/hip_runtime.h>
#include <hip/hip_bf16.h>
#include <cstdio>
#include <cstdint>
namespace att {
using bf16 = __hip_bfloat16;
constexpr int   D = 128, NW = 8, QBLK = 32, KVBLK = 64;
constexpr float SCALE = 0.088388347648318440f;
constexpr float THR = 8.f;
constexpr int SDEPTH = 2;
constexpr int LDQ = 2048, LDK = 512, LDO = 2048;
constexpr size_t SHM_V = KVBLK * D * 2, SHM_K = KVBLK * D * 2, SHM_ATTN = 2 * SHM_V + 2 * SHM_K + NW * 64 * 4;
using bf16x8 = __attribute__((ext_vector_type(8))) short;
using s16x4  = __attribute__((ext_vector_type(4))) short;
using f32x16 = __attribute__((ext_vector_type(16))) float;
using f32x8  = __attribute__((ext_vector_type(8))) float;
using u32x4  = __attribute__((ext_vector_type(4))) unsigned;
#define KSWZ(row, colB) ((row) * 256 + ((colB) ^ (((row) & 7) << 4)))
#define SBAR() __builtin_amdgcn_sched_barrier(0)
__device__ __forceinline__ int crow(int r, int hi) { return (r & 3) + 8 * (r >> 2) + 4 * hi; }
__device__ __forceinline__ unsigned cvtpk(float lo, float hi) {
  unsigned r; asm volatile("v_cvt_pk_bf16_f32 %0, %1, %2" : "=v"(r) : "v"(lo), "v"(hi)); return r;
}
template <typename TIn> struct Stage;
template <> struct Stage<bf16>  { using T = bf16x8;
  __device__ static __forceinline__ T ld8(const bf16* p) { return *reinterpret_cast<const bf16x8*>(p); }
  __device__ static __forceinline__ bf16x8 tobf(T x) { return x; } };
template <> struct Stage<float> { using T = f32x8;
  __device__ static __forceinline__ T ld8(const float* p) { return *reinterpret_cast<const f32x8*>(p); }
  __device__ static __forceinline__ bf16x8 tobf(T x) {
    u32x4 w = {cvtpk(x[0], x[1]), cvtpk(x[2], x[3]), cvtpk(x[4], x[5]), cvtpk(x[6], x[7])}; return *reinterpret_cast<bf16x8*>(&w); } };

__device__ __forceinline__ void partialSM(f32x16& p0, f32x16& p1, float& m_reg, float& mn, float& alpha) {
  constexpr float C = SCALE * 1.4426950408889634f;
  float pmax = p0[0]; for (int r = 1; r < 16; ++r) pmax = fmaxf(pmax, p0[r]); for (int r = 0; r < 16; ++r) pmax = fmaxf(pmax, p1[r]);
  { auto rr = __builtin_amdgcn_permlane32_swap(__float_as_uint(pmax), __float_as_uint(pmax), false, false);
    pmax = fmaxf(__uint_as_float(rr[0]), __uint_as_float(rr[1])); }
  if (__builtin_expect(__all(pmax - m_reg <= THR / SCALE), 1)) { mn = m_reg; alpha = 1.f; }
  else { mn = fmaxf(m_reg, pmax); alpha = __builtin_amdgcn_exp2f((m_reg - mn) * C); m_reg = mn; }
  float mnC = -mn * C;
  for (int r = 0; r < 16; ++r) p0[r] = fmaf(p0[r], C, mnC); for (int r = 0; r < 16; ++r) p1[r] = fmaf(p1[r], C, mnC);
  for (int r = 0; r < 16; ++r) p0[r] = __builtin_amdgcn_exp2f(p0[r]);
}
__device__ __forceinline__ void finishSM(f32x16& p0, f32x16& p1, float alpha, float& l_reg, bf16x8& pa0, bf16x8& pa1, bf16x8& pa2, bf16x8& pa3) {
  for (int r = 0; r < 16; ++r) p1[r] = __builtin_amdgcn_exp2f(p1[r]);
  float ps = 0; for (int r = 0; r < 16; ++r) ps += p0[r]; for (int r = 0; r < 16; ++r) ps += p1[r];
  { auto rr = __builtin_amdgcn_permlane32_swap(__float_as_uint(ps), __float_as_uint(ps), false, false);
    ps = __uint_as_float(rr[0]) + __uint_as_float(rr[1]); }
  l_reg = l_reg * alpha + ps;
#define PK4(P, BASE, OUT) do { unsigned a0 = cvtpk(P[BASE + 0], P[BASE + 1]), a1 = cvtpk(P[BASE + 2], P[BASE + 3]);   \
    unsigned b0 = cvtpk(P[BASE + 4], P[BASE + 5]), b1 = cvtpk(P[BASE + 6], P[BASE + 7]);                              \
    auto r0 = __builtin_amdgcn_permlane32_swap(a0, b0, false, false); auto r1 = __builtin_amdgcn_permlane32_swap(a1, b1, false, false); \
    u32x4 w = {r0[0], r1[0], r0[1], r1[1]}; OUT = *reinterpret_cast<bf16x8*>(&w); } while (0)
  PK4(p0, 0, pa0); PK4(p0, 8, pa1); PK4(p1, 0, pa2); PK4(p1, 8, pa3);
#undef PK4
}
__device__ __forceinline__ void qkt(f32x16& p0, f32x16& p1, const bf16* Ks, const bf16x8* qr, int r32, int hi) {
  p0 = f32x16{}; p1 = f32x16{};
  for (int d0 = 0; d0 < 8; ++d0) { int cb = (d0 * 16 + hi * 8) * 2;
    bf16x8 b0 = *reinterpret_cast<const bf16x8*>((const char*)Ks + KSWZ(r32, cb));
    bf16x8 b1 = *reinterpret_cast<const bf16x8*>((const char*)Ks + KSWZ(32 + r32, cb));
    p0 = __builtin_amdgcn_mfma_f32_32x32x16_bf16(b0, qr[d0], p0, 0, 0, 0);
    p1 = __builtin_amdgcn_mfma_f32_32x32x16_bf16(b1, qr[d0], p1, 0, 0, 0); }
}
__device__ __forceinline__ int v_st(int k, int c) { const int kk = (k & ~0xC) | ((k & 4) << 1) | ((k & 8) >> 1); return ((kk >> 3) * 4 + (c >> 5)) * 512 + ((kk & 7) * 32 + (c & 31)) * 2; }
__device__ __forceinline__ int v_rd_base(int lane) { return ((lane & 3) << 3) | (((lane >> 2) & 3) << 6) | (((lane >> 4) & 1) << 5) | (((lane >> 5) & 1) << 8); }
constexpr int v_rd_off(int d0, int ks, int half) { return d0 * 512 + ks * 4096 + half * 2048; }
template <int OFF> __device__ __forceinline__ s16x4 tr_read(int vb) {
  s16x4 r; asm volatile("ds_read_b64_tr_b16 %0, %1 offset:%2" : "=&v"(r) : "v"(vb), "i"(OFF) : "memory"); return r;
}
template <int D0> __device__ __forceinline__ void pv_one(f32x16& od, int vb, bf16x8 pa0, bf16x8 pa1, bf16x8 pa2, bf16x8 pa3) {
  const s16x4 l0 = tr_read<v_rd_off(D0, 0, 0)>(vb), h0 = tr_read<v_rd_off(D0, 0, 1)>(vb), l1 = tr_read<v_rd_off(D0, 1, 0)>(vb), h1 = tr_read<v_rd_off(D0, 1, 1)>(vb);
  const s16x4 l2 = tr_read<v_rd_off(D0, 2, 0)>(vb), h2 = tr_read<v_rd_off(D0, 2, 1)>(vb), l3 = tr_read<v_rd_off(D0, 3, 0)>(vb), h3 = tr_read<v_rd_off(D0, 3, 1)>(vb);
  asm volatile("s_waitcnt lgkmcnt(0)" ::: "memory"); SBAR();
#define PK(L, H) (bf16x8){L[0], L[1], L[2], L[3], H[0], H[1], H[2], H[3]}
  od = __builtin_amdgcn_mfma_f32_32x32x16_bf16(pa0, PK(l0, h0), od, 0, 0, 0);
  od = __builtin_amdgcn_mfma_f32_32x32x16_bf16(pa1, PK(l1, h1), od, 0, 0, 0);
  od = __builtin_amdgcn_mfma_f32_32x32x16_bf16(pa2, PK(l2, h2), od, 0, 0, 0);
  od = __builtin_amdgcn_mfma_f32_32x32x16_bf16(pa3, PK(l3, h3), od, 0, 0, 0);
#undef PK
}
__device__ __forceinline__ void pv_d0(f32x16* o, int vb, bf16x8 pa0, bf16x8 pa1, bf16x8 pa2, bf16x8 pa3) {
  pv_one<0>(o[0], vb, pa0, pa1, pa2, pa3); pv_one<1>(o[1], vb, pa0, pa1, pa2, pa3); pv_one<2>(o[2], vb, pa0, pa1, pa2, pa3); pv_one<3>(o[3], vb, pa0, pa1, pa2, pa3);
}

__device__ __forceinline__ void st_out(float* p, float v) { *p = v; }
__device__ __forceinline__ void st_out(bf16* p, float v) { *p = __float2bfloat16(v); }
template <typename TQ, typename TO>
__device__ __forceinline__ void attn_dense_body(const TQ* __restrict__ Qb, const bf16* __restrict__ Kh, const bf16* __restrict__ Vh,
                                                TO* __restrict__ Ob, int seq, char* lds) {
  using St = Stage<bf16>; using SQ = Stage<TQ>;
  const int tid = threadIdx.x, wid = tid >> 6, lane = tid & 63, r32 = lane & 31, hi = lane >> 5;
  bf16* V_lds = (bf16*)lds; bf16* K_lds = (bf16*)(lds + 2 * SHM_V);
  float* ws = (float*)(lds + 2 * SHM_V + 2 * SHM_K) + wid * 64; float* li_l = ws; float* al_l = ws + 32;
  float m_reg = -1e30f, l_reg = 0; f32x16 o[4] = {}; bf16x8 qr[8];
  const TQ* Qw = Qb + (long)(wid * QBLK + r32) * LDQ + hi * 8;
#pragma unroll
  for (int d0 = 0; d0 < 8; ++d0) qr[d0] = SQ::tobf(SQ::ld8(Qw + d0 * 16));
  const int sr = tid >> 4, sc = (tid & 15) * 8, vst0 = v_st(sr, sc), vst1 = v_st(32 + sr, sc);
  const int vb0 = (int)(uintptr_t)V_lds + v_rd_base(lane);
  struct { typename St::T vs0, vs1, ks0, ks1; } sr_[SDEPTH];
#define SLOAD(i, k0) do { sr_[i].vs0 = St::ld8(&Vh[(long)((k0) + sr) * LDK + sc]); sr_[i].vs1 = St::ld8(&Vh[(long)((k0) + 32 + sr) * LDK + sc]); \
    sr_[i].ks0 = St::ld8(&Kh[(long)((k0) + sr) * LDK + sc]); sr_[i].ks1 = St::ld8(&Kh[(long)((k0) + 32 + sr) * LDK + sc]); } while (0)
#define SWRITE(b, i) do { *(bf16x8*)((char*)V_lds + (b) * SHM_V + vst0) = St::tobf(sr_[i].vs0);          \
    *(bf16x8*)((char*)V_lds + (b) * SHM_V + vst1) = St::tobf(sr_[i].vs1); int kc = sc * 2;               \
    *(bf16x8*)((char*)K_lds + (b) * SHM_K + KSWZ(sr, kc)) = St::tobf(sr_[i].ks0);                       \
    *(bf16x8*)((char*)K_lds + (b) * SHM_K + KSWZ(32 + sr, kc)) = St::tobf(sr_[i].ks1); } while (0)
#define SWAIT() do { if constexpr (SDEPTH == 2) asm volatile("s_waitcnt vmcnt(4)" ::: "memory"); else asm volatile("s_waitcnt vmcnt(0)" ::: "memory"); } while (0)
#define RESC(a) do { if (__any((a) < 1.f)) { if (hi == 0) al_l[r32] = (a); asm volatile("s_waitcnt lgkmcnt(0)" ::: "memory"); \
    for (int d = 0; d < 4; ++d) for (int r = 0; r < 16; ++r) o[d][r] *= al_l[crow(r, hi)]; } } while (0)
  f32x16 pA0, pA1, pB0, pB1; float mnA, mnB, alA, alB; bf16x8 pa0, pa1, pa2, pa3; const int NT = seq / KVBLK;
  constexpr int SE = 0, SO = SDEPTH - 1;
  SLOAD(SE, 0); asm volatile("s_waitcnt vmcnt(0)" ::: "memory"); SWRITE(0, SE); __syncthreads();
  qkt(pA0, pA1, K_lds, qr, r32, hi); partialSM(pA0, pA1, m_reg, mnA, alA);
  SLOAD(SO, KVBLK); if constexpr (SDEPTH == 2) { if (2 < NT) SLOAD(SE, 2 * KVBLK); }
  SWAIT(); SWRITE(1, SO); __syncthreads();
  for (int j = 1; j + 1 < NT; j += 2) {
    SBAR(); qkt(pB0, pB1, (bf16*)((char*)K_lds + SHM_K), qr, r32, hi);
    finishSM(pA0, pA1, alA, l_reg, pa0, pa1, pa2, pa3); SBAR();
    SLOAD(SO, (j + SDEPTH) * KVBLK); SBAR();
    pv_d0(o, vb0, pa0, pa1, pa2, pa3); partialSM(pB0, pB1, m_reg, mnB, alB);
    __syncthreads(); SWAIT(); SWRITE(0, SE);
    RESC(alB); __syncthreads();
    SBAR(); qkt(pA0, pA1, K_lds, qr, r32, hi);
    finishSM(pB0, pB1, alB, l_reg, pa0, pa1, pa2, pa3); SBAR();
    if (SDEPTH == 1 || j + 3 < NT) SLOAD(SE, (j + 1 + SDEPTH) * KVBLK); SBAR();
    pv_d0(o, vb0 + (int)SHM_V, pa0, pa1, pa2, pa3); partialSM(pA0, pA1, m_reg, mnA, alA);
    __syncthreads(); SWAIT(); SWRITE(1, SO);
    RESC(alA); __syncthreads();
  }
  SBAR(); qkt(pB0, pB1, (bf16*)((char*)K_lds + SHM_K), qr, r32, hi);
  finishSM(pA0, pA1, alA, l_reg, pa0, pa1, pa2, pa3); SBAR();
  pv_d0(o, vb0, pa0, pa1, pa2, pa3); partialSM(pB0, pB1, m_reg, mnB, alB);
  __syncthreads(); RESC(alB);
  finishSM(pB0, pB1, alB, l_reg, pa0, pa1, pa2, pa3); SBAR();
  pv_d0(o, vb0 + (int)SHM_V, pa0, pa1, pa2, pa3);
  if (hi == 0) li_l[r32] = l_reg; asm volatile("s_waitcnt lgkmcnt(0)" ::: "memory");
  float rli[16];
#pragma unroll
  for (int r = 0; r < 16; ++r) rli[r] = __builtin_amdgcn_rcpf(li_l[crow(r, hi)]);
  TO* Ow = Ob + (long)(wid * QBLK) * LDO;
#pragma unroll
  for (int r = 0; r < 16; ++r) { int orow = crow(r, hi);
    for (int d0 = 0; d0 < 4; ++d0) st_out(&Ow[(long)orow * LDO + d0 * 32 + r32], o[d0][r] * rli[r]); }
#undef SLOAD
#undef SWRITE
#undef SWAIT
#undef RESC
}

using i32x8 = __attribute__((ext_vector_type(8))) int;
constexpr int LDQ8 = 2048, LDK8 = 512;
constexpr size_t SHM_K8 = KVBLK * D;
#define KSWZ8(row, colB) ((row) * 128 + ((colB) ^ (((row) & 7) << 4)))
__device__ __forceinline__ i32x8 cat8(u32x4 a, u32x4 b) { const __attribute__((ext_vector_type(8))) unsigned w = __builtin_shufflevector(a, b, 0, 1, 2, 3, 4, 5, 6, 7); return __builtin_bit_cast(i32x8, w); }
__device__ __forceinline__ void qkt8(f32x16& p0, f32x16& p1, const char* Ks, const i32x8* qr, int r32, int hi) {
  p0 = f32x16{}; p1 = f32x16{};
#pragma unroll
  for (int t = 0; t < 2; ++t) { const int cb = 64 * t + 32 * hi;
    const u32x4 a0 = *reinterpret_cast<const u32x4*>(Ks + KSWZ8(r32, cb)), a1 = *reinterpret_cast<const u32x4*>(Ks + KSWZ8(r32, cb + 16));
    const u32x4 b0 = *reinterpret_cast<const u32x4*>(Ks + KSWZ8(32 + r32, cb)), b1 = *reinterpret_cast<const u32x4*>(Ks + KSWZ8(32 + r32, cb + 16));
    p0 = __builtin_amdgcn_mfma_scale_f32_32x32x64_f8f6f4(cat8(a0, a1), qr[t], p0, 0, 0, 0, 0, 0, 0);
    p1 = __builtin_amdgcn_mfma_scale_f32_32x32x64_f8f6f4(cat8(b0, b1), qr[t], p1, 0, 0, 0, 0, 0, 0); }
}
template <typename TO>
__device__ __forceinline__ void attn_dense_body_f8(const unsigned char* __restrict__ Qb, const unsigned char* __restrict__ Kh, const bf16* __restrict__ Vh,
                                                   TO* __restrict__ Ob, int seq, char* lds) {
  using St = Stage<bf16>;
  const int tid = threadIdx.x, wid = tid >> 6, lane = tid & 63, r32 = lane & 31, hi = lane >> 5;
  bf16* V_lds = (bf16*)lds; bf16* K_lds = (bf16*)(lds + 2 * SHM_V);
  float* ws = (float*)(lds + 2 * SHM_V + 2 * SHM_K) + wid * 64; float* li_l = ws; float* al_l = ws + 32;
  float m_reg = -1e30f, l_reg = 0; f32x16 o[4] = {}; i32x8 qr[2];
  const unsigned char* Qw = Qb + (long)(wid * QBLK + r32) * LDQ8 + hi * 32;
#pragma unroll
  for (int t = 0; t < 2; ++t) { const u32x4 lo = *reinterpret_cast<const u32x4*>(Qw + 64 * t), up = *reinterpret_cast<const u32x4*>(Qw + 64 * t + 16); qr[t] = cat8(lo, up); }
  const int krow = tid >> 3, kch = (tid & 7) * 16, kst = KSWZ8(krow, kch);
  const int sr = tid >> 4, sc = (tid & 15) * 8, vst0 = v_st(sr, sc), vst1 = v_st(32 + sr, sc);
  const int vb0 = (int)(uintptr_t)V_lds + v_rd_base(lane);
  struct { typename St::T vs0, vs1; u32x4 ks; } sr_[SDEPTH];
#define SLOAD(i, k0) do { sr_[i].vs0 = St::ld8(&Vh[(long)((k0) + sr) * LDK + sc]); sr_[i].vs1 = St::ld8(&Vh[(long)((k0) + 32 + sr) * LDK + sc]); \
    sr_[i].ks = *reinterpret_cast<const u32x4*>(Kh + (long)((k0) + krow) * LDK8 + kch); } while (0)
#define SWRITE(b, i) do { *(bf16x8*)((char*)V_lds + (b) * SHM_V + vst0) = St::tobf(sr_[i].vs0);          \
    *(bf16x8*)((char*)V_lds + (b) * SHM_V + vst1) = St::tobf(sr_[i].vs1);                                \
    *(u32x4*)((char*)K_lds + (b) * SHM_K8 + kst) = sr_[i].ks; } while (0)
#define SWAIT() do { if constexpr (SDEPTH == 2) asm volatile("s_waitcnt vmcnt(3)" ::: "memory"); else asm volatile("s_waitcnt vmcnt(0)" ::: "memory"); } while (0)
#define RESC(a) do { if (__any((a) < 1.f)) { if (hi == 0) al_l[r32] = (a); asm volatile("s_waitcnt lgkmcnt(0)" ::: "memory"); \
    for (int d = 0; d < 4; ++d) for (int r = 0; r < 16; ++r) o[d][r] *= al_l[crow(r, hi)]; } } while (0)
  f32x16 pA0, pA1, pB0, pB1; float mnA, mnB, alA, alB; bf16x8 pa0, pa1, pa2, pa3; const int NT = seq / KVBLK;
  constexpr int SE = 0, SO = SDEPTH - 1;
  SLOAD(SE, 0); asm volatile("s_waitcnt vmcnt(0)" ::: "memory"); SWRITE(0, SE); __syncthreads();
  qkt8(pA0, pA1, (const char*)K_lds, qr, r32, hi); partialSM(pA0, pA1, m_reg, mnA, alA);
  SLOAD(SO, KVBLK); if constexpr (SDEPTH == 2) { if (2 < NT) SLOAD(SE, 2 * KVBLK); }
  SWAIT(); SWRITE(1, SO); __syncthreads();
  for (int j = 1; j + 1 < NT; j += 2) {
    SBAR(); qkt8(pB0, pB1, (const char*)K_lds + SHM_K8, qr, r32, hi);
    finishSM(pA0, pA1, alA, l_reg, pa0, pa1, pa2, pa3); SBAR();
    SLOAD(SO, (j + SDEPTH) * KVBLK); SBAR();
    pv_d0(o, vb0, pa0, pa1, pa2, pa3); partialSM(pB0, pB1, m_reg, mnB, alB);
    __syncthreads(); SWAIT(); SWRITE(0, SE);
    RESC(alB); __syncthreads();
    SBAR(); qkt8(pA0, pA1, (const char*)K_lds, qr, r32, hi);
    finishSM(pB0, pB1, alB, l_reg, pa0, pa1, pa2, pa3); SBAR();
    if (SDEPTH == 1 || j + 3 < NT) SLOAD(SE, (j + 1 + SDEPTH) * KVBLK); SBAR();
    pv_d0(o, vb0 + (int)SHM_V, pa0, pa1, pa2, pa3); partialSM(pA0, pA1, m_reg, mnA, alA);
    __syncthreads(); SWAIT(); SWRITE(1, SO);
    RESC(alA); __syncthreads();
  }
  SBAR(); qkt8(pB0, pB1, (const char*)K_lds + SHM_K8, qr, r32, hi);
  finishSM(pA0, pA1, alA, l_reg, pa0, pa1, pa2, pa3); SBAR();
  pv_d0(o, vb0, pa0, pa1, pa2, pa3); partialSM(pB0, pB1, m_reg, mnB, alB);
  __syncthreads(); RESC(alB);
  finishSM(pB0, pB1, alB, l_reg, pa0, pa1, pa2, pa3); SBAR();
  pv_d0(o, vb0 + (int)SHM_V, pa0, pa1, pa2, pa3);
  if (hi == 0) li_l[r32] = l_reg; asm volatile("s_waitcnt lgkmcnt(0)" ::: "memory");
  float rli[16];
#pragma unroll
  for (int r = 0; r < 16; ++r) rli[r] = __builtin_amdgcn_rcpf(li_l[crow(r, hi)]);
  TO* Ow = Ob + (long)(wid * QBLK) * LDO;
#pragma unroll
  for (int r = 0; r < 16; ++r) { int orow = crow(r, hi);
    for (int d0 = 0; d0 < 4; ++d0) st_out(&Ow[(long)orow * LDO + d0 * 32 + r32], o[d0][r] * rli[r]); }
#undef SLOAD
#undef SWRITE
#undef SWAIT
#undef RESC
}


constexpr float THR8 = 0.5f;
constexpr size_t SHM_V8 = KVBLK * D;
#define VSWZ8(row, ch) ((row) * 64 + (((ch) ^ (((row) >> 2) & 3)) << 4))
__device__ __forceinline__ void partialSM8(f32x16& p0, f32x16& p1, float& m_reg, float& mn, float& alpha) {
  constexpr float C = SCALE * 1.4426950408889634f;
  float pmax = p0[0]; for (int r = 1; r < 16; ++r) pmax = fmaxf(pmax, p0[r]); for (int r = 0; r < 16; ++r) pmax = fmaxf(pmax, p1[r]);
  { auto rr = __builtin_amdgcn_permlane32_swap(__float_as_uint(pmax), __float_as_uint(pmax), false, false);
    pmax = fmaxf(__uint_as_float(rr[0]), __uint_as_float(rr[1])); }
  if (__builtin_expect(__all(pmax - m_reg <= THR8 / SCALE), 1)) { mn = m_reg; alpha = 1.f; }
  else { mn = fmaxf(m_reg, pmax); alpha = __builtin_amdgcn_exp2f((m_reg - mn) * C); m_reg = mn; }
  float mnC = -mn * C + 8.f;
  for (int r = 0; r < 16; ++r) p0[r] = fmaf(p0[r], C, mnC); for (int r = 0; r < 16; ++r) p1[r] = fmaf(p1[r], C, mnC);
  for (int r = 0; r < 16; ++r) p0[r] = __builtin_amdgcn_exp2f(p0[r]);
}
__device__ __forceinline__ void finishSM8(f32x16& p0, f32x16& p1, float alpha, float& l_reg, i32x8& pa) {
  for (int r = 0; r < 16; ++r) p1[r] = __builtin_amdgcn_exp2f(p1[r]);
  float ps = 0; for (int r = 0; r < 16; ++r) ps += p0[r]; for (int r = 0; r < 16; ++r) ps += p1[r];
  { auto rr = __builtin_amdgcn_permlane32_swap(__float_as_uint(ps), __float_as_uint(ps), false, false);
    ps = __uint_as_float(rr[0]) + __uint_as_float(rr[1]); }
  l_reg = l_reg * alpha + ps;
#pragma unroll
  for (int w = 0; w < 4; ++w) { int x = __builtin_amdgcn_cvt_pk_fp8_f32(p0[4 * w], p0[4 * w + 1], pa[w], false); x = __builtin_amdgcn_cvt_pk_fp8_f32(p0[4 * w + 2], p0[4 * w + 3], x, true); pa[w] = x;
    int y = __builtin_amdgcn_cvt_pk_fp8_f32(p1[4 * w], p1[4 * w + 1], pa[4 + w], false); y = __builtin_amdgcn_cvt_pk_fp8_f32(p1[4 * w + 2], p1[4 * w + 3], y, true); pa[4 + w] = y; }
}
__device__ __forceinline__ void pv8(f32x16* o, const char* Vs, int r32, int hi, i32x8 pa) {
#pragma unroll
  for (int d0 = 0; d0 < 4; ++d0) { const int row = d0 * 32 + r32;
    const u32x4 lo = *reinterpret_cast<const u32x4*>(Vs + VSWZ8(row, 2 * hi)), up = *reinterpret_cast<const u32x4*>(Vs + VSWZ8(row, 2 * hi + 1));
    o[d0] = __builtin_amdgcn_mfma_scale_f32_32x32x64_f8f6f4(pa, cat8(lo, up), o[d0], 0, 0, 0, 0, 0, 0); }
}
constexpr float QK_FOLD = 0.35706690f;
constexpr float TARG8 = 8.f + THR8 * 1.4426950408889634f;
__device__ __forceinline__ void qkt8b(f32x16& p0, f32x16& p1, const char* Ks, const i32x8* qr, int r32, int hi, const f32x16& cb) {
  { const int cb0 = 32 * hi;
    const u32x4 a0 = *reinterpret_cast<const u32x4*>(Ks + KSWZ8(r32, cb0)), a1 = *reinterpret_cast<const u32x4*>(Ks + KSWZ8(r32, cb0 + 16));
    const u32x4 b0 = *reinterpret_cast<const u32x4*>(Ks + KSWZ8(32 + r32, cb0)), b1 = *reinterpret_cast<const u32x4*>(Ks + KSWZ8(32 + r32, cb0 + 16));
    p0 = __builtin_amdgcn_mfma_scale_f32_32x32x64_f8f6f4(cat8(a0, a1), qr[0], cb, 0, 0, 0, 0, 0, 0);
    p1 = __builtin_amdgcn_mfma_scale_f32_32x32x64_f8f6f4(cat8(b0, b1), qr[0], cb, 0, 0, 0, 0, 0, 0); }
  { const int cb1 = 64 + 32 * hi;
    const u32x4 a0 = *reinterpret_cast<const u32x4*>(Ks + KSWZ8(r32, cb1)), a1 = *reinterpret_cast<const u32x4*>(Ks + KSWZ8(r32, cb1 + 16));
    const u32x4 b0 = *reinterpret_cast<const u32x4*>(Ks + KSWZ8(32 + r32, cb1)), b1 = *reinterpret_cast<const u32x4*>(Ks + KSWZ8(32 + r32, cb1 + 16));
    p0 = __builtin_amdgcn_mfma_scale_f32_32x32x64_f8f6f4(cat8(a0, a1), qr[1], p0, 0, 0, 0, 0, 0, 0);
    p1 = __builtin_amdgcn_mfma_scale_f32_32x32x64_f8f6f4(cat8(b0, b1), qr[1], p1, 0, 0, 0, 0, 0, 0); }
}
template <bool FIRST>
__device__ __forceinline__ void partialSM8b(f32x16& p0, f32x16& p1, f32x16& cb, float& alpha) {
  float pmax = p0[0]; for (int r = 1; r < 16; ++r) pmax = fmaxf(pmax, p0[r]); for (int r = 0; r < 16; ++r) pmax = fmaxf(pmax, p1[r]);
  { auto rr = __builtin_amdgcn_permlane32_swap(__float_as_uint(pmax), __float_as_uint(pmax), false, false);
    pmax = fmaxf(__uint_as_float(rr[0]), __uint_as_float(rr[1])); }
  if (!FIRST && __builtin_expect(__all(pmax <= TARG8), 1)) { alpha = 1.f; }
  else { const float delta = FIRST ? (pmax - 8.f) : fmaxf(pmax - 8.f, 0.f);
    alpha = FIRST ? 1.f : __builtin_amdgcn_exp2f(-delta);
    for (int r = 0; r < 16; ++r) { p0[r] -= delta; p1[r] -= delta; cb[r] -= delta; } }
  for (int r = 0; r < 16; ++r) p0[r] = __builtin_amdgcn_exp2f(p0[r]);
}
template <typename TO>
__device__ __forceinline__ void attn_dense_body_f8pv(const unsigned char* __restrict__ Qb, const unsigned char* __restrict__ Kh, const unsigned char* __restrict__ Vt,
                                                     TO* __restrict__ Ob, int seq, char* lds) {
  const int tid = threadIdx.x, wid = __builtin_amdgcn_readfirstlane(tid >> 6), lane = tid & 63, r32 = lane & 31, hi = lane >> 5;
  char* V_lds = lds; char* K_lds = lds + 4 * SHM_V8;
  float* ws = (float*)(lds + 4 * SHM_V8 + 4 * SHM_K8) + wid * 64; float* li_l = ws; float* al_l = ws + 32;
  float l_reg = 0; f32x16 o[4] = {}; i32x8 qr[2]; f32x16 cb; for (int r = 0; r < 16; ++r) cb[r] = 8.f;
  const unsigned char* Qw = Qb + (long)(wid * QBLK + r32) * LDQ8 + hi * 32;
#pragma unroll
  for (int t = 0; t < 2; ++t) { const u32x4 lo = *reinterpret_cast<const u32x4*>(Qw + 64 * t), up = *reinterpret_cast<const u32x4*>(Qw + 64 * t + 16); qr[t] = cat8(lo, up); }
  const int krow = tid >> 3, vrow = tid >> 2;
  const unsigned char* kp = Kh + (long)krow * LDK8 + (((tid & 7) ^ (krow & 7)) << 4);
  const unsigned char* vp = Vt + vrow * 64 + (((tid & 3) ^ ((vrow >> 2) & 3)) << 4);
#define GLDS16(g, l) __builtin_amdgcn_global_load_lds((const unsigned*)(g), (__attribute__((address_space(3))) unsigned*)(l), 16, 0, 0)
#define DMA(tile, slot) do { GLDS16(kp + (long)(tile) * (KVBLK * LDK8), K_lds + (slot) * SHM_K8 + wid * 1024); GLDS16(vp + (long)(tile) * SHM_V8, V_lds + (slot) * SHM_V8 + wid * 1024); } while (0)
#define WAITV(n) asm volatile("s_waitcnt vmcnt(" #n ")" ::: "memory")
#define BAR() do { __builtin_amdgcn_s_barrier(); asm volatile("" ::: "memory"); } while (0)
#define RESC(a) do { if (__any((a) < 1.f)) { if (hi == 0) al_l[r32] = (a); asm volatile("s_waitcnt lgkmcnt(0)" ::: "memory"); \
    for (int d = 0; d < 4; ++d) for (int r = 0; r < 16; ++r) o[d][r] *= al_l[crow(r, hi)]; } } while (0)
  f32x16 pA0, pA1, pB0, pB1; float alA, alB; i32x8 pa = {}; const int NT = seq / KVBLK;
  DMA(0, 0); DMA(1, 1);
  WAITV(2); BAR();
  DMA(2, 2);
  qkt8b(pA0, pA1, K_lds, qr, r32, hi, cb); partialSM8b<true>(pA0, pA1, cb, alA);
  WAITV(2); BAR();
#define STEP(jj, PC0, PC1, alC, PP0, PP1, alP, slotK, slotVp, slotD) \
  if ((jj) < NT) { const bool more = (jj) + 2 < NT; if (more) DMA((jj) + 2, slotD); \
    SBAR(); qkt8b(PC0, PC1, K_lds + (slotK) * SHM_K8, qr, r32, hi, cb); \
    finishSM8(PP0, PP1, alP, l_reg, pa); SBAR(); \
    pv8(o, V_lds + (slotVp) * SHM_V8, r32, hi, pa); partialSM8b<false>(PC0, PC1, cb, alC); \
    if (more) WAITV(2); else WAITV(0); \
    BAR(); RESC(alC); }
  for (int j = 1; j < NT; j += 4) {
    STEP(j,     pB0, pB1, alB, pA0, pA1, alA, 1, 0, 3)
    STEP(j + 1, pA0, pA1, alA, pB0, pB1, alB, 2, 1, 0)
    STEP(j + 2, pB0, pB1, alB, pA0, pA1, alA, 3, 2, 1)
    STEP(j + 3, pA0, pA1, alA, pB0, pB1, alB, 0, 3, 2)
  }
  finishSM8(pB0, pB1, alB, l_reg, pa); SBAR();
  pv8(o, V_lds + 3 * SHM_V8, r32, hi, pa);
  if (hi == 0) li_l[r32] = l_reg; asm volatile("s_waitcnt lgkmcnt(0)" ::: "memory");
  float rli[16];
#pragma unroll
  for (int r = 0; r < 16; ++r) rli[r] = __builtin_amdgcn_rcpf(li_l[crow(r, hi)]);
  TO* Ow = Ob + (long)(wid * QBLK) * LDO;
#pragma unroll
  for (int r = 0; r < 16; ++r) { int orow = crow(r, hi);
    for (int d0 = 0; d0 < 4; ++d0) st_out(&Ow[(long)orow * LDO + d0 * 32 + r32], o[d0][r] * rli[r]); }
#undef GLDS16
#undef DMA
#undef WAITV
#undef BAR
#undef RESC
#undef STEP
}

}
namespace pg {
#define PG_LAS __attribute__((address_space(3)))
typedef unsigned short bf16_t;
typedef short bf16x8 __attribute__((ext_vector_type(8)));
typedef float f32x4 __attribute__((ext_vector_type(4)));
typedef float f32x2 __attribute__((ext_vector_type(2)));
typedef unsigned u32x4 __attribute__((ext_vector_type(4)));
typedef unsigned u32x2 __attribute__((ext_vector_type(2)));
constexpr int BM = 256, BK = 64, HALF = 128, HTB = HALF * BK * 2, STAGE_BYTES = 8 * HTB;

__host__ __device__ __forceinline__ int lds_byte(int r, int c) { const int st = (r >> 4) * 2 + (c >> 5), rr = r & 15, cc = c & 31, ob = rr * 64 + cc * 2; return st * 1024 + (ob ^ (((ob >> 9) & 1) << 5)); }
__host__ __device__ __forceinline__ void stage_rc(int b, int& R, int& C) { const int st = b / 1024, sb = b % 1024, swz = sb ^ (((sb >> 9) & 1) << 5); R = (st >> 1) * 16 + swz / 64; C = (st & 1) * 32 + (swz % 64) / 2; }
__host__ __device__ __forceinline__ int perm32(int rho) { const int n = rho >> 4, i = rho & 15; return 8 * (i >> 2) + 4 * n + (i & 3); }
__device__ __forceinline__ unsigned cvt_pk_bf16(float lo, float hi) { unsigned r; asm volatile("v_cvt_pk_bf16_f32 %0, %1, %2" : "=v"(r) : "v"(lo), "v"(hi)); return r; }
typedef __bf16 bf16x2_t __attribute__((ext_vector_type(2)));
__device__ __forceinline__ unsigned cvt_pk_c(float lo, float hi) { const f32x2 v = {lo, hi}; const bf16x2_t b = __builtin_convertvector(v, bf16x2_t); return __builtin_bit_cast(unsigned, b); }

struct Unit { int pm, pn, z, aux, half; };

typedef int i32x8 __attribute__((ext_vector_type(8)));
template <class Epi, class Prob, bool GATHER, bool FP8 = false, int XM = 0>
__device__ __forceinline__ void gemm_phase(PG_LAS unsigned char* lds, const Prob& S, const Epi& E) {
    const int tid = threadIdx.x, wid = __builtin_amdgcn_readfirstlane(tid >> 6), lane = tid & 63, wr = wid >> 2, wc = wid & 3, fr = lane & 15, fq = lane >> 4;
    int nt = S.K / BK; asm volatile("" : "+s"(nt));
    unsigned voffA[2], voffB[2]; int RA[2], CA[2];
#pragma unroll
    for (int i = 0; i < 2; ++i) { int R, C; stage_rc(tid * 16 + i * 8192, R, C); const int Rb = Epi::PERM ? ((R & ~31) + perm32(R & 31)) : R;
        RA[i] = R; CA[i] = C; voffA[i] = GATHER ? (unsigned)(C * 2) : S.a_off(R, C); voffB[i] = S.b_off(Rb, C); }
    const size_t kstep = (size_t)(BK * 2);
    const size_t hA = GATHER ? 0 : S.hstepA, hB = S.hstepB;
    const unsigned ldsw = (unsigned)wid * 1024u;
    const int aoff = lds_byte(wr * 64 + fr, fq * 8), boff = lds_byte(wc * 32 + fr, fq * 8);
#define PG_SA(b, h) (((b) * 2 + (h)) * HTB)
#define PG_SB(b, h) ((4 + (b) * 2 + (h)) * HTB)
#define PG_GLDS(gptr, ldsoff) if constexpr (!(XM & 4)) __builtin_amdgcn_global_load_lds((const unsigned*)(gptr), (PG_LAS unsigned*)(lds + (ldsoff)), 16, 0, 0)
#define PG_STAGE_A(bufoff, base, G, h, kb) do { const char* _ub = (base) + (kb) + (GATHER ? (size_t)0 : (size_t)(h) * hA); \
        _Pragma("unroll") for (int _i = 0; _i < 2; ++_i) { unsigned _o = GATHER ? (G)[h][_i] : voffA[_i]; asm volatile("" : "+v"(_o)); PG_GLDS(_ub + _o, (bufoff) + ldsw + _i * 8192); } } while (0)
#define PG_STAGE_B(bufoff, base, h, kb) do { const char* _ub = (base) + (kb) + (size_t)(h) * hB; \
        _Pragma("unroll") for (int _i = 0; _i < 2; ++_i) { unsigned _o = voffB[_i]; asm volatile("" : "+v"(_o)); PG_GLDS(_ub + _o, (bufoff) + ldsw + _i * 8192); } } while (0)
#define PG_LDA(dst, b, h) do { if constexpr (!(XM & 2)) _Pragma("unroll") for (int m = 0; m < 4; ++m) _Pragma("unroll") for (int k = 0; k < 2; ++k) dst[m][k] = *(const PG_LAS bf16x8*)(lds + PG_SA(b, h) + aoff + m * 2048 + k * 1024); } while (0)
#define PG_LDB(dst, b, h) do { if constexpr (!(XM & 2)) _Pragma("unroll") for (int n = 0; n < 2; ++n) _Pragma("unroll") for (int k = 0; k < 2; ++k) dst[n][k] = *(const PG_LAS bf16x8*)(lds + PG_SB(b, h) + boff + n * 2048 + k * 1024); } while (0)
#define PG_CAT(x) __builtin_shufflevector(__builtin_bit_cast(u32x4, (x)[0]), __builtin_bit_cast(u32x4, (x)[1]), 0, 1, 2, 3, 4, 5, 6, 7)
#define PG_MMA(ai, bj, At, Bt) do { __builtin_amdgcn_s_setprio(1); _Pragma("unroll") for (int m = 0; m < 4; ++m) _Pragma("unroll") for (int n = 0; n < 2; ++n) { \
        if constexpr ((XM & 1) != 0) { asm volatile("" :: "v"(At[m][0]), "v"(At[m][1]), "v"(Bt[n][0]), "v"(Bt[n][1])); } else \
        if constexpr (FP8) acc[ai][bj][m][n] = __builtin_amdgcn_mfma_scale_f32_16x16x128_f8f6f4(__builtin_bit_cast(i32x8, PG_CAT(Bt[n])), __builtin_bit_cast(i32x8, PG_CAT(At[m])), acc[ai][bj][m][n], 0, 0, 0, 0, 0, 0); \
        else { _Pragma("unroll") for (int k = 0; k < 2; ++k) acc[ai][bj][m][n] = __builtin_amdgcn_mfma_f32_16x16x32_bf16(Bt[n][k], At[m][k], acc[ai][bj][m][n], 0, 0, 0); } } \
        __builtin_amdgcn_s_setprio(0); } while (0)
#define PG_WAIT_V(n) asm volatile("s_waitcnt vmcnt(" #n ")" ::: "memory")
#define PG_WAIT_L(n) asm volatile("s_waitcnt lgkmcnt(" #n ")" ::: "memory")
#define PG_BAR __builtin_amdgcn_s_barrier()
#define PG_SCHED __builtin_amdgcn_sched_barrier(0)
#define PG_AROWS(G, U) do { if (GATHER) { _Pragma("unroll") for (int _h = 0; _h < 2; ++_h) _Pragma("unroll") for (int _i = 0; _i < 2; ++_i) (G)[_h][_i] = S.a_row((U), RA[_i] + 128 * _h) + voffA[_i]; } } while (0)
    Unit cur, nxt; int ui = 0;
    if (!S.next(0, cur)) return;
    f32x4 acc[2][2][4][2];
#pragma unroll
    for (int a = 0; a < 2; ++a)
#pragma unroll
        for (int b = 0; b < 2; ++b)
#pragma unroll
            for (int m = 0; m < 4; ++m)
#pragma unroll
                for (int n = 0; n < 2; ++n) acc[a][b][m][n] = (f32x4){0.f, 0.f, 0.f, 0.f};
    bf16x8 At[4][2], B0[2][2], B1[2][2];
    if constexpr ((XM & 2) != 0) {
#pragma unroll
        for (int q = 0; q < 4; ++q)
#pragma unroll
            for (int k = 0; k < 2; ++k) { u32x4 w; for (int e = 0; e < 4; ++e) w[e] = ((unsigned)(lane + 1) * 0x9E3779B1u + (unsigned)(q * 8 + k * 4 + e + 1) * 0x85EBCA6Bu) & ((XM & 8) ? 0u : 0x7E7E7E7Eu); asm volatile("" : "+v"(w));
                At[q][k] = __builtin_bit_cast(bf16x8, w); if (q < 2) { B0[q][k] = __builtin_bit_cast(bf16x8, w); B1[q][k] = __builtin_bit_cast(bf16x8, w); } }
    }
    unsigned gc[2][2] = {{0u, 0u}, {0u, 0u}}, gn[2][2] = {{0u, 0u}, {0u, 0u}};
    const char* cA = S.a_base(cur); const char* cB = S.b_base(cur);
    PG_AROWS(gc, cur);
    PG_STAGE_B(PG_SB(0, 0), cB, 0, 0); PG_STAGE_B(PG_SB(0, 1), cB, 1, 0); PG_STAGE_A(PG_SA(0, 0), cA, gc, 0, 0); PG_STAGE_A(PG_SA(0, 1), cA, gc, 1, 0);
    if (wr == 1) PG_BAR;
    PG_WAIT_V(2); PG_BAR;
    PG_STAGE_B(PG_SB(1, 0), cB, 0, kstep); PG_STAGE_A(PG_SA(1, 0), cA, gc, 0, kstep); PG_STAGE_B(PG_SB(1, 1), cB, 1, kstep);
    PG_WAIT_V(6); PG_BAR;
    for (;;) {
        const bool has_next = S.next(ui + 1, nxt);
        int hflag = __builtin_amdgcn_readfirstlane(cur.half); asm volatile("" : "+s"(hflag));
        const bool chalf = hflag != 0;
        const char* nA = has_next ? S.a_base(nxt) : cA; const char* nB = has_next ? S.b_base(nxt) : cB;
        if (GATHER) { if (has_next) { PG_AROWS(gn, nxt); } else {
#pragma unroll
            for (int _h = 0; _h < 2; ++_h)
#pragma unroll
                for (int _i = 0; _i < 2; ++_i) gn[_h][_i] = gc[_h][_i]; } }
        for (int t = 0; t < nt; t += 2) {
            const bool last = (t == nt - 2);
            const size_t k1 = (size_t)(t + 1) * kstep;
            const char* a2 = last ? nA : cA + (size_t)(t + 2) * kstep; const char* b2 = last ? nB : cB + (size_t)(t + 2) * kstep;
            unsigned g2[2][2];
#pragma unroll
            for (int _h = 0; _h < 2; ++_h)
#pragma unroll
                for (int _i = 0; _i < 2; ++_i) g2[_h][_i] = last ? gn[_h][_i] : gc[_h][_i];
            PG_LDB(B0, 0, 0); PG_LDB(B1, 0, 1); PG_SCHED; PG_LDA(At, 0, 0); PG_STAGE_A(PG_SA(1, 1), cA, gc, 1, k1);
            PG_WAIT_V(8); PG_WAIT_L(0); PG_BAR; PG_MMA(0, 0, At, B0); PG_MMA(0, 1, At, B1); PG_BAR; PG_SCHED;
            if (!chalf) PG_LDA(At, 0, 1); PG_STAGE_B(PG_SB(0, 0), b2, 0, 0); PG_STAGE_B(PG_SB(0, 1), b2, 1, 0); PG_STAGE_A(PG_SA(0, 0), a2, g2, 0, 0);
            PG_WAIT_V(8); PG_WAIT_L(0); PG_BAR; if (!chalf) { PG_MMA(1, 0, At, B0); PG_MMA(1, 1, At, B1); } PG_BAR; PG_SCHED;
            PG_LDB(B0, 1, 0); PG_LDB(B1, 1, 1); PG_SCHED; PG_LDA(At, 1, 0); PG_STAGE_A(PG_SA(0, 1), a2, g2, 1, 0);
            PG_WAIT_V(8); PG_WAIT_L(0); PG_BAR; PG_MMA(0, 0, At, B0); PG_MMA(0, 1, At, B1); PG_BAR; PG_SCHED;
            if (!chalf) PG_LDA(At, 1, 1); PG_STAGE_B(PG_SB(1, 0), b2, 0, kstep); PG_STAGE_B(PG_SB(1, 1), b2, 1, kstep); PG_STAGE_A(PG_SA(1, 0), a2, g2, 0, kstep);
            PG_WAIT_V(8); PG_WAIT_L(0); PG_BAR; if (!chalf) { PG_MMA(1, 0, At, B0); PG_MMA(1, 1, At, B1); } PG_BAR; PG_SCHED;
        }
        if (wr == 0) PG_BAR;
        E(acc, cur, wr, wc, fr, fq);
        if (!has_next) break;
#pragma unroll
        for (int a = 0; a < 2; ++a)
#pragma unroll
            for (int b = 0; b < 2; ++b)
#pragma unroll
                for (int m = 0; m < 4; ++m)
#pragma unroll
                    for (int n = 0; n < 2; ++n) acc[a][b][m][n] = (f32x4){0.f, 0.f, 0.f, 0.f};
        cur = nxt; cA = nA; cB = nB; ++ui;
        if (GATHER) {
#pragma unroll
            for (int _h = 0; _h < 2; ++_h)
#pragma unroll
                for (int _i = 0; _i < 2; ++_i) gc[_h][_i] = gn[_h][_i]; }
        if (wr == 1) PG_BAR;
    }
    PG_WAIT_V(0);
    PG_BAR;
#undef PG_SA
#undef PG_SB
#undef PG_GLDS
#undef PG_STAGE_A
#undef PG_STAGE_B
#undef PG_LDA
#undef PG_LDB
#undef PG_MMA
#undef PG_CAT
#undef PG_WAIT_V
#undef PG_WAIT_L
#undef PG_BAR
#undef PG_SCHED
#undef PG_AROWS
}
}
namespace mk {
#define GAS __attribute__((address_space(1)))
#define LAS __attribute__((address_space(3)))
typedef unsigned short bf16;
typedef float f32x4 __attribute__((ext_vector_type(4)));
typedef float f32x2 __attribute__((ext_vector_type(2)));
typedef short bf16x8 __attribute__((ext_vector_type(8)));
typedef unsigned u32x4 __attribute__((ext_vector_type(4)));
typedef unsigned u32x2 __attribute__((ext_vector_type(2)));
using pg::cvt_pk_bf16;

constexpr int D = 2048, SEQ = 16384, CTX = 256, T = SEQ + CTX, NE = 32, DE = 1024, CAP = T;
constexpr int NWAVES = 8, NTHR = 512;
#ifndef MK_MOE_FP8
#define MK_MOE_FP8 1
#endif
#ifndef MK_ATT_FP8
#define MK_ATT_FP8 1
#endif
#ifndef MK_ATT_PV8
#define MK_ATT_PV8 1
#endif
constexpr bool ATT_FP8 = MK_ATT_FP8 != 0;
constexpr bool ATT_PV8 = ATT_FP8 && (MK_ATT_PV8 != 0);
#ifndef MK_D8
#define MK_D8 6
#endif
constexpr bool CIN_FP8 = (MK_D8 & 1) != 0, QKV_FP8 = (MK_D8 & 2) != 0, GLU_FP8 = (MK_D8 & 4) != 0;
constexpr float D8_WSCALE = 32.f;
constexpr bool MOE_FP8 = MK_MOE_FP8 != 0;
constexpr int MOE_EB = MOE_FP8 ? 1 : 2;
constexpr float MOE_WSCALE = MOE_FP8 ? 32.f : 1.f;
constexpr int MT = T / 256;
constexpr int ACT_ROWS = T * 4 + NE * 256;

constexpr size_t al256(size_t x) { return (x + 255) / 256 * 256; }
constexpr size_t WS_CTL = 0, CTL_BYTES = 1u << 20;
constexpr int CW_BAR = 1024;
constexpr int CW_CNT = 8192;
constexpr int CW_MOD = 16384;
static_assert((CW_MOD + 4 * 2 * 6 * D) * 4 <= (int)CTL_BYTES, "ctl");
constexpr size_t WS_WT_F = CTL_BYTES;
constexpr size_t WS_WT_CIN = WS_WT_F + (size_t)D * D * 2;
constexpr size_t WS_WT_COUT = WS_WT_CIN + (size_t)3 * D * D * 2;
constexpr size_t WS_WT_QKV = WS_WT_COUT + (size_t)D * D * 2;
constexpr size_t WS_WT_WO = WS_WT_QKV + (size_t)3072 * D * 2;
constexpr size_t WS_WT_GLU = WS_WT_WO + (size_t)D * D * 2;
constexpr size_t WS_WT_W1 = WS_WT_GLU + (size_t)2 * D * D * 2;
constexpr size_t WS_WT_W2 = WS_WT_W1 + (size_t)4 * NE * 2 * DE * D * 2;
constexpr size_t WS_DT = WS_WT_W2 + (size_t)4 * NE * D * DE * 2;
constexpr size_t WS_DM1 = WS_DT + 512 * 256 * 2;
constexpr size_t WS_DM2 = WS_DM1 + 256 * 256 * 2;
constexpr size_t WS_DM256 = WS_DM2 + 256 * 256 * 2;
constexpr size_t WS_X = WS_DM256 + 256 * 512 * 2;
constexpr size_t WS_H = WS_X + (size_t)T * D * 4;
constexpr size_t WS_H2 = WS_H + (size_t)T * D * 2;
constexpr size_t WS_REC = WS_H2 + (size_t)T * D * 2;
constexpr size_t WS_GATE = WS_REC + (size_t)T * 4 * 8;
constexpr size_t WS_TOKL = WS_GATE + (size_t)T * 4 * 4;
constexpr size_t WS_ACT = al256(WS_TOKL + (size_t)NE * CAP * 4);
constexpr size_t WS_YB = WS_ACT + (size_t)ACT_ROWS * DE * 2;
constexpr size_t WS_ARENA = al256(WS_YB + (size_t)ACT_ROWS * D * 2);
constexpr size_t AR_L1 = 0;
constexpr size_t AR_LC = AR_L1 + (size_t)128 * 4096 * 128 * 2;
constexpr size_t AR_L2 = AR_LC + (size_t)4096 * 256 * 2;
constexpr size_t AR_F = AR_L2 + (size_t)128 * 4096 * 128 * 2;
constexpr size_t AR_GB = 0, AR_S = AR_GB + (size_t)T * D * 2, AR_A2 = AR_S + (size_t)T * D * 2;
constexpr size_t AR_QR = 0, AR_KR = AR_QR + (size_t)T * D * 2, AR_VR = AR_KR + (size_t)T * 512 * 2, AR_QB = AR_VR + (size_t)T * 512 * 2,
                 AR_KB = AR_QB + (size_t)T * D * 2, AR_VB = AR_KB + (size_t)T * 512 * 2, AR_O = AR_VB + (size_t)T * 512 * 2, AR_V8T = AR_O + (size_t)T * D * 2;
constexpr size_t AR_YD = 0, AR_Z = AR_YD + (size_t)2 * SEQ * D * 4, AR_SS = AR_Z + (size_t)SEQ * D * 2;
constexpr size_t AR_SS_END = AR_SS + (size_t)256 * 1040 * 128 * 4;
constexpr size_t AR_END = (AR_F + (size_t)T * D * 2) > AR_SS_END ? (AR_F + (size_t)T * D * 2) : AR_SS_END;
constexpr size_t WS_FAST_END = WS_ARENA + AR_END;

constexpr int RING_BYTES = 131072;
constexpr int SCR_BYTES = 8 * 128 * 33 * 4;
constexpr int MISC_OFF = 139264;
constexpr int LDS_BYTES = 147456;
static_assert(SCR_BYTES <= MISC_OFF && RING_BYTES <= MISC_OFF && MISC_OFF + 8192 <= LDS_BYTES, "LDS map");

#define XB_TMO      128
#define XB_XCNT(j)  (256  + 64 * (j))
#define XB_XSUB(j)  (1280 + 64 * (j))
#define XB_XGEN(j)  (2304 + 64 * (j))
#define XB_TOP      3328
#define XB_TOPGEN   3392
#define XCD_BAR_WORDS 3456
#define XB_SPIN_CAP (1u << 18)
__device__ __forceinline__ unsigned xb_ld(unsigned* p)              { return __hip_atomic_load(p, __ATOMIC_RELAXED, __HIP_MEMORY_SCOPE_AGENT); }
__device__ __forceinline__ unsigned xb_add(unsigned* p, unsigned v) { return __hip_atomic_fetch_add(p, v, __ATOMIC_RELAXED, __HIP_MEMORY_SCOPE_AGENT); }
__device__ __forceinline__ unsigned xb_xcc_id() { return (unsigned)__builtin_amdgcn_s_getreg((3 << 11) | 20) & 0xFu; }
#define XB_SPIN(cond, bar) do { unsigned _sp = 0; while (cond) { __builtin_amdgcn_s_sleep(1); \
    if ((++_sp & 255u) == 0u) { if (xb_ld(&(bar)[XB_TMO])) break; if (_sp > XB_SPIN_CAP) { atomicAdd(&(bar)[XB_TMO], 1u); break; } } } } while (0)
struct XcdBarrier { unsigned* bar; unsigned x; volatile LAS unsigned* st; };
__device__ __forceinline__ XcdBarrier xcd_barrier_post(unsigned* bar, volatile LAS unsigned* st) {
    XcdBarrier b; b.bar = bar; b.x = xb_xcc_id(); b.st = st;
    if (threadIdx.x == 0) (void)xb_add(&bar[XB_XCNT(b.x)], 1u);
    return b;
}
__device__ __forceinline__ void xcd_barrier_complete(unsigned* bar, unsigned x, unsigned& nloc, unsigned& nx) {
    const unsigned G = gridDim.x * gridDim.y * gridDim.z;
    unsigned sum, cnt, mine, sp = 0u;
    for (;;) {
        sum = 0u; cnt = 0u; mine = 0u;
#pragma unroll
        for (unsigned j = 0; j < 16; ++j) { const unsigned c = xb_ld(&bar[XB_XCNT(j)]); sum += c; cnt += (c > 0u) ? 1u : 0u; mine = (j == x) ? c : mine; }
        if (sum == G) break;
        __builtin_amdgcn_s_sleep(1);
        if ((++sp & 255u) == 0u) { if (xb_ld(&bar[XB_TMO])) break; if (sp > XB_SPIN_CAP) { atomicAdd(&bar[XB_TMO], 1u); break; } }
    }
    nloc = mine > 0u ? mine : 1u; nx = cnt > 0u ? cnt : 1u;
}
__device__ __forceinline__ void xcd_barrier(const XcdBarrier& b) {
    asm volatile("s_waitcnt vmcnt(0)" ::: "memory");
    __syncthreads();
    if (threadIdx.x == 0) {
        unsigned* bar = b.bar;
        __builtin_amdgcn_s_waitcnt(0);
        unsigned nloc = b.st[0], nx = b.st[1];
        if (nloc == 0u) { xcd_barrier_complete(bar, b.x, nloc, nx); b.st[0] = nloc; b.st[1] = nx; }
        const unsigned old = xb_add(&bar[XB_XSUB(b.x)], 1u);
        const unsigned gen = old / nloc;
        if (old + 1u == (gen + 1u) * nloc) {
            __builtin_amdgcn_fence(__ATOMIC_RELEASE, "agent");
            asm volatile("s_waitcnt vmcnt(0)" ::: "memory");
            const unsigned og = xb_add(&bar[XB_TOP], 1u);
            const unsigned tg = og / nx;
            if (og + 1u == (tg + 1u) * nx) xb_add(&bar[XB_TOPGEN], 1u);
            else XB_SPIN(xb_ld(&bar[XB_TOPGEN]) == tg, bar);
            __builtin_amdgcn_fence(__ATOMIC_ACQUIRE, "agent");
            xb_add(&bar[XB_XGEN(b.x)], 1u);
            asm volatile("s_waitcnt vmcnt(0)" ::: "memory");
        } else {
            XB_SPIN(xb_ld(&bar[XB_XGEN(b.x)]) == gen, bar);
            __builtin_amdgcn_fence(__ATOMIC_ACQUIRE, "agent");
            asm volatile("s_waitcnt vmcnt(0)" ::: "memory");
        }
    }
    __syncthreads();
}

struct Args { const float* in[36]; float* out; unsigned char* ws; const float* xin; int ph_lo, ph_hi; };
struct Frame {
    LAS unsigned char* lds; volatile LAS unsigned* MISC;
    unsigned* ctl; unsigned char* ws; unsigned char* ar;
    int tid, lane, wave, vcu, G, gw, NGW;
};
template <int CTRL> __device__ __forceinline__ float dpp_get(float v) { return __int_as_float(__builtin_amdgcn_update_dpp(0, __float_as_int(v), CTRL, 0xf, 0xf, true)); }
__device__ __forceinline__ float wave_sum(float v) {
    v += dpp_get<0xB1>(v); v += dpp_get<0x4E>(v); v += dpp_get<0x124>(v); v += dpp_get<0x128>(v);
    v += __int_as_float(__builtin_amdgcn_ds_swizzle(__float_as_int(v), 0x401f));
    { const auto rr = __builtin_amdgcn_permlane32_swap(__float_as_uint(v), __float_as_uint(v), false, false); v = __uint_as_float(rr[0]) + __uint_as_float(rr[1]); }
    return v;
}
__device__ __forceinline__ float silu_f(float x) { return x * __builtin_amdgcn_rcpf(1.f + __expf(-x)); }
__device__ __forceinline__ float sigm_f(float x) { return __builtin_amdgcn_rcpf(1.f + __expf(-x)); }
__device__ __forceinline__ float gelu_tanh_f(float x) { const float u = 0.7978845608028654f * (x + 0.044715f * x * x * x); const float e = __expf(2.f * u); return 0.5f * x * (1.f + (1.f - 2.f * __builtin_amdgcn_rcpf(e + 1.f))); }
__device__ __forceinline__ float bf2f(unsigned short b) { return __uint_as_float(((unsigned)b) << 16); }
__device__ __forceinline__ float bflo(unsigned w) { return __uint_as_float(w << 16); }
__device__ __forceinline__ float bfhi(unsigned w) { return __uint_as_float(w & 0xffff0000u); }
}
namespace mk {
struct TrIt { const float* W; bf16* WT; int ldw, K, N, hs, roff, r, f8; };
constexpr int TR_SCR = 128 * 33 * 4;
__device__ __forceinline__ void tr_load(const TrIt& d, f32x4 (&v)[16], int lane) {
    if (d.f8 == 2) { const int nblk = d.N / 32, kb = d.r / nblk, nb = d.r % nblk, k0 = 128 * kb, n0 = 32 * nb;
#pragma unroll
        for (int j = 0; j < 16; ++j) v[j] = __builtin_nontemporal_load((const GAS f32x4*)(d.W + (size_t)(k0 + (lane >> 3) + 8 * j) * d.ldw + n0 + 4 * (lane & 7)));
        return; }
    const int nblk = d.N / 64, kb = d.r / nblk, nb = d.r % nblk, k0 = 64 * kb, n0 = 64 * nb;
#pragma unroll
    for (int j = 0; j < 16; ++j) v[j] = __builtin_nontemporal_load((const GAS f32x4*)(d.W + (size_t)(k0 + (lane >> 4) + 4 * j) * d.ldw + n0 + 4 * (lane & 15)));
}
__device__ __forceinline__ void tr_store(const TrIt& d, const f32x4 (&v)[16], LAS float* scr, int lane) {
    if (d.f8 == 2) { const int nblk = d.N / 32, kb = d.r / nblk, nb = d.r % nblk, k0 = 128 * kb, n0 = 32 * nb;
#pragma unroll
        for (int j = 0; j < 16; ++j) { LAS float* s = scr + ((lane >> 3) + 8 * j) * 33 + 4 * (lane & 7); s[0] = v[j].x; s[1] = v[j].y; s[2] = v[j].z; s[3] = v[j].w; }
        asm volatile("s_waitcnt lgkmcnt(0)" ::: "memory");
        int nrow0;
        if (d.hs) { const int h = n0 / d.hs, j = n0 % d.hs; nrow0 = (j / 128) * 256 + h * 128 + (j % 128); } else nrow0 = n0;
        nrow0 += d.roff;
        const int c = lane & 7;
#pragma unroll
        for (int j = 0; j < 4; ++j) { const int n = (lane >> 3) + 8 * j; const LAS float* s = scr + (16 * c) * 33 + n; u32x4 o;
#pragma unroll
            for (int q = 0; q < 4; ++q) { int w = __builtin_amdgcn_cvt_pk_fp8_f32(s[(4 * q) * 33] * 32.f, s[(4 * q + 1) * 33] * 32.f, 0, false); w = __builtin_amdgcn_cvt_pk_fp8_f32(s[(4 * q + 2) * 33] * 32.f, s[(4 * q + 3) * 33] * 32.f, w, true); o[q] = (unsigned)w; }
            __builtin_nontemporal_store(o, (GAS u32x4*)((unsigned char*)d.WT + (size_t)(nrow0 + n) * d.K + k0 + 16 * c)); }
        asm volatile("s_waitcnt lgkmcnt(0)" ::: "memory");
        return; }
    const int nblk = d.N / 64, kb = d.r / nblk, nb = d.r % nblk, k0 = 64 * kb, n0 = 64 * nb;
#pragma unroll
    for (int j = 0; j < 16; ++j) { LAS float* s = scr + ((lane >> 4) + 4 * j) * 65 + 4 * (lane & 15); s[0] = v[j].x; s[1] = v[j].y; s[2] = v[j].z; s[3] = v[j].w; }
    asm volatile("s_waitcnt lgkmcnt(0)" ::: "memory");
    int nrow0;
    if (d.hs) { const int h = n0 / d.hs, j = n0 % d.hs; nrow0 = (j / 128) * 256 + h * 128 + (j % 128); } else nrow0 = n0;
    nrow0 += d.roff;
    const int c = lane & 7;
    if (d.f8) {
#pragma unroll
        for (int j = 0; j < 8; ++j) { const int n = (lane >> 3) + 8 * j; const LAS float* s = scr + (8 * c) * 65 + n;
            int w0 = __builtin_amdgcn_cvt_pk_fp8_f32(s[0 * 65] * 32.f, s[1 * 65] * 32.f, 0, false); w0 = __builtin_amdgcn_cvt_pk_fp8_f32(s[2 * 65] * 32.f, s[3 * 65] * 32.f, w0, true);
            int w1 = __builtin_amdgcn_cvt_pk_fp8_f32(s[4 * 65] * 32.f, s[5 * 65] * 32.f, 0, false); w1 = __builtin_amdgcn_cvt_pk_fp8_f32(s[6 * 65] * 32.f, s[7 * 65] * 32.f, w1, true);
            __builtin_nontemporal_store((u32x2){(unsigned)w0, (unsigned)w1}, (GAS u32x2*)((unsigned char*)d.WT + (size_t)(nrow0 + n) * d.K + k0 + 8 * c)); }
    } else {
#pragma unroll
        for (int j = 0; j < 8; ++j) { const int n = (lane >> 3) + 8 * j; const LAS float* s = scr + (8 * c) * 65 + n;
            u32x4 o; o.x = cvt_pk_bf16(s[0 * 65], s[1 * 65]); o.y = cvt_pk_bf16(s[2 * 65], s[3 * 65]); o.z = cvt_pk_bf16(s[4 * 65], s[5 * 65]); o.w = cvt_pk_bf16(s[6 * 65], s[7 * 65]);
            __builtin_nontemporal_store(o, (GAS u32x4*)(d.WT + (size_t)(nrow0 + n) * d.K + k0 + 8 * c)); }
    }
    asm volatile("s_waitcnt lgkmcnt(0)" ::: "memory");
}

constexpr int TR_I_DD = (D / 64) * (D / 64), TR_I_D2D = (D / 64) * (2 * D / 64), TR_I_DK = (D / 64) * (512 / 64);
constexpr int TR_I_W1 = (D / 64) * (2 * DE / 64), TR_I_W2 = (DE / 64) * (D / 64);
constexpr int TR_N_SMALL = 4 * TR_I_DD + 2 * TR_I_D2D + TR_I_DD + 2 * TR_I_DK, TR_NL = NE * (TR_I_W1 + TR_I_W2);
__device__ __forceinline__ int tr_moe_lo(int l) { return TR_N_SMALL + l * TR_NL; }
__device__ __forceinline__ TrIt tr_decode(const Args& a, unsigned char* ws, int it) {
    int r = it;
#define TR_ITEM(cnt, W, ldw, K, N, WT, hs, roff, f8) if (r < (cnt)) return TrIt{(W), (WT), (ldw), (K), (N), (hs), (roff), r, (f8)}; r -= (cnt);
    TR_ITEM(TR_I_DD,  a.in[8],      D,     D, D,     (bf16*)(ws + WS_WT_F),    0, 0, 0)
    TR_ITEM(TR_I_DD,  a.in[10],     3 * D, D, D,     (bf16*)(ws + WS_WT_CIN),  0, 0, CIN_FP8 ? 1 : 0)
    TR_ITEM(TR_I_D2D, a.in[10] + D, 3 * D, D, 2 * D, (bf16*)(ws + WS_WT_CIN),  D, D, CIN_FP8 ? 1 : 0)
    TR_ITEM(TR_I_DD,  a.in[13],     D,     D, D,     (bf16*)(ws + WS_WT_COUT), 0, 0, 0)
    TR_ITEM(TR_I_DD,  a.in[14],     D,     D, D,     (bf16*)(ws + WS_WT_QKV),  0, 0, QKV_FP8 ? 1 : 0)
    TR_ITEM(TR_I_DK,  a.in[15],     512,   D, 512,   (bf16*)(ws + WS_WT_QKV),  0, 2048, QKV_FP8 ? 1 : 0)
    TR_ITEM(TR_I_DK,  a.in[16],     512,   D, 512,   (bf16*)(ws + WS_WT_QKV),  0, 2560, QKV_FP8 ? 1 : 0)
    TR_ITEM(TR_I_DD,  a.in[17],     D,     D, D,     (bf16*)(ws + WS_WT_WO),   0, 0, 0)
    TR_ITEM(TR_I_D2D, a.in[28],     2 * D, D, 2 * D, (bf16*)(ws + WS_WT_GLU),  D, 0, GLU_FP8 ? 1 : 0)
#undef TR_ITEM
    const int l = r / TR_NL; r -= l * TR_NL;
    if (r < NE * TR_I_W1) { const int b = l * NE + r / TR_I_W1; return TrIt{a.in[32] + (size_t)b * D * 2 * DE, (bf16*)(ws + WS_WT_W1 + (size_t)b * 2 * DE * D * MOE_EB), 2 * DE, D, 2 * DE, DE, 0, r % TR_I_W1, MOE_FP8 ? 2 : 0}; }
    r -= NE * TR_I_W1;
    { const int b = l * NE + r / TR_I_W2; return TrIt{a.in[34] + (size_t)b * DE * D, (bf16*)(ws + WS_WT_W2 + (size_t)b * D * DE * MOE_EB), D, DE, D, 0, 0, r % TR_I_W2, MOE_FP8 ? 2 : 0}; }
}
#ifdef MK_EXP
__device__ __forceinline__ void read_items(Frame& F, const Args& a, int lo, int hi, int widx, int wstride) {
    unsigned acc = 0u;
    for (int it = lo + widx; it < hi; it += 2 * wstride) {
        TrIt c0 = tr_decode(a, F.ws, it); f32x4 va[16], vb[16];
        tr_load(c0, va, F.lane);
        const bool has = it + wstride < hi;
        if (has) { TrIt c1 = tr_decode(a, F.ws, it + wstride); tr_load(c1, vb, F.lane); }
#pragma unroll
        for (int j = 0; j < 16; ++j) acc ^= __float_as_uint(va[j].x) ^ __float_as_uint(va[j].w);
        if (has) {
#pragma unroll
            for (int j = 0; j < 16; ++j) acc ^= __float_as_uint(vb[j].y) ^ __float_as_uint(vb[j].z); }
    }
    if (acc == 0x12345678u) F.ctl[CW_MOD + 4 * 2 * 6 * D + 64] = acc;
}
#endif
__device__ __forceinline__ void convert_items(Frame& F, const Args& a, int lo, int hi, int widx, int wstride) {
    LAS float* scr = (LAS float*)(F.lds + F.wave * TR_SCR);
    int it = lo + widx;
    if (it >= hi) return;
    f32x4 va[16], vb[16];
    TrIt ca = tr_decode(a, F.ws, it), cb = ca;
    tr_load(ca, va, F.lane);
    for (;;) {
        const int i1 = it + wstride; const bool h1 = i1 < hi;
        if (h1) { cb = tr_decode(a, F.ws, i1); tr_load(cb, vb, F.lane); }
        tr_store(ca, va, scr, F.lane);
        if (!h1) break;
        const int i2 = i1 + wstride; const bool h2 = i2 < hi;
        if (h2) { ca = tr_decode(a, F.ws, i2); tr_load(ca, va, F.lane); }
        tr_store(cb, vb, scr, F.lane);
        if (!h2) break;
        it = i2;
    }
}
constexpr int BG_F0 = 22;
constexpr int BG_F1A = 30, BG_F1B = 52;
constexpr int BG_F2A = 22, BG_F2B = 44;

__device__ __forceinline__ void p0_prologue(Frame& F, const Args& a) {
    unsigned char* ws = F.ws;
    {
        convert_items(F, a, 0, TR_N_SMALL, F.gw, F.NGW);
        convert_items(F, a, tr_moe_lo(0) + (TR_NL / 64) * BG_F0, tr_moe_lo(1), F.gw, F.NGW);
        convert_items(F, a, tr_moe_lo(1) + (TR_NL / 64) * BG_F1B, tr_moe_lo(2), F.gw, F.NGW);
        convert_items(F, a, tr_moe_lo(2) + (TR_NL / 64) * BG_F2B, tr_moe_lo(4), F.gw, F.NGW);
    }
    {
        bf16* DT = (bf16*)(ws + WS_DT); bf16* DM1 = (bf16*)(ws + WS_DM1); bf16* DM2 = (bf16*)(ws + WS_DM2); bf16* DM256 = (bf16*)(ws + WS_DM256);
        const int gt = F.gw * 64 + F.lane, NGT = F.NGW * 64;
        for (int i = gt; i < 512 * 256; i += NGT) {
            const int mm = i >> 8, k = i & 255, chp = mm >> 1, c = mm & 1; const float x = (float)((chp * k) & 255) * (1.f / 256.f);
            const float v = c ? -__builtin_amdgcn_sinf(x) : __builtin_amdgcn_cosf(x);
            DT[i] = (bf16)(cvt_pk_bf16(v, 0.f) & 0xffffu);
        }
        for (int i = gt; i < 256 * 256; i += NGT) {
            const int row = i >> 8, col = i & 255, cp = row >> 7, p = row & 127, c = col >> 7, aa = col & 127;
            const float x = (float)((p * aa) & 127) * (1.f / 128.f); const float cs = __builtin_amdgcn_cosf(x), sn = __builtin_amdgcn_sinf(x);
            const float v1 = (cp == c) ? cs : (cp == 0 ? sn : -sn);
            DM1[i] = (bf16)(cvt_pk_bf16(v1, 0.f) & 0xffffu);
            const float v2 = (row < 128) ? (c == 0 ? cs : sn) : 0.f;
            DM2[i] = (bf16)(cvt_pk_bf16(v2, 0.f) & 0xffffu);
        }
        for (int i = gt; i < 256 * 512; i += NGT) {
            const int k = i >> 9, col = i & 511, c = col >> 8, n = col & 255; const float x = (float)((k * n) & 255) * (1.f / 256.f);
            const float v = c ? __builtin_amdgcn_sinf(x) : __builtin_amdgcn_cosf(x);
            DM256[i] = (bf16)(cvt_pk_bf16(v, 0.f) & 0xffffu);
        }
    }
    {
        float* MOD = (float*)(F.ctl + CW_MOD);
        const float* c = a.in[1]; const float* cc = a.in[3]; const float* aw = a.in[4]; const float* ab = a.in[5];
        LAS float* sl = (LAS float*)F.lds;
        LAS f32x4* red = (LAS f32x4*)(F.lds + 16384);
        __syncthreads();
        for (int k = F.tid; k < D; k += NTHR) { sl[k] = silu_f(c[k]); sl[D + k] = silu_f(cc[k]); }
        __syncthreads();
        const int NIT = 4 * 192, cq = F.tid & 15, kq = F.tid >> 4;
        for (int it = F.vcu; it < NIT; it += F.G) {
            const int l = it / 192, j = (it % 192) * 64 + 4 * cq;
            const float* w = aw + ((size_t)l * D + kq * 64) * 6 * D + j;
            f32x4 a0 = (f32x4){0.f, 0.f, 0.f, 0.f}, a1 = (f32x4){0.f, 0.f, 0.f, 0.f};
#pragma unroll 1
            for (int k0 = 0; k0 < 64; k0 += 16) {
                f32x4 wv[16];
#pragma unroll
                for (int k = 0; k < 16; ++k) wv[k] = __builtin_nontemporal_load((const GAS f32x4*)(w + (size_t)(k0 + k) * 6 * D));
#pragma unroll
                for (int k = 0; k < 16; ++k) { a0 += sl[kq * 64 + k0 + k] * wv[k]; a1 += sl[D + kq * 64 + k0 + k] * wv[k]; }
            }
            red[kq * 16 + cq] = a0; red[512 + kq * 16 + cq] = a1;
            __syncthreads();
            if (F.tid < 32) { const int w2 = F.tid >> 4, q4 = F.tid & 15; f32x4 sres = *(const GAS f32x4*)(ab + (size_t)l * 6 * D + (it % 192) * 64 + 4 * q4);
#pragma unroll 1
                for (int g2 = 0; g2 < 32; ++g2) sres += red[w2 * 512 + g2 * 16 + q4];
                *(GAS f32x4*)(MOD + ((size_t)l * 2 + w2) * 6 * D + (it % 192) * 64 + 4 * q4) = sres; }
            __syncthreads();
        }
    }
}
}
namespace mk {
__device__ __forceinline__ void norm_phase(Frame& F, const float* Xl, const float* Xc, const float* g, const float* modl, bf16* H, int nrows) {
    for (int row = F.gw; row < nrows; row += F.NGW) {
        const float* xrow = row < SEQ ? Xl + (size_t)row * D : Xc + (size_t)(row - SEQ) * D;
        const float* m = modl + (size_t)(row >= SEQ ? 1 : 0) * 6 * D;
        f32x4 v[8], gg[8], sh[8], sc[8]; float s = 0.f;
#pragma unroll
        for (int j = 0; j < 4; ++j) { const int c = 8 * (F.lane + 64 * j); const GAS f32x4* p = (const GAS f32x4*)(xrow + c); v[2 * j] = p[0]; v[2 * j + 1] = p[1];
            gg[2 * j] = *(const GAS f32x4*)(g + c); gg[2 * j + 1] = *(const GAS f32x4*)(g + c + 4); sh[2 * j] = *(const GAS f32x4*)(m + c); sh[2 * j + 1] = *(const GAS f32x4*)(m + c + 4);
            sc[2 * j] = *(const GAS f32x4*)(m + D + c); sc[2 * j + 1] = *(const GAS f32x4*)(m + D + c + 4); }
#pragma unroll
        for (int j = 0; j < 8; ++j) s += (v[j].x * v[j].x + v[j].y * v[j].y) + (v[j].z * v[j].z + v[j].w * v[j].w);
        const float r = rsqrtf(wave_sum(s) * (1.f / D) + 1e-6f);
#pragma unroll
        for (int j = 0; j < 4; ++j) { const int c = 8 * (F.lane + 64 * j);
            const f32x4 y0 = v[2 * j] * r * gg[2 * j] * (sc[2 * j] + 1.f) + sh[2 * j], y1 = v[2 * j + 1] * r * gg[2 * j + 1] * (sc[2 * j + 1] + 1.f) + sh[2 * j + 1];
            u32x4 w; w.x = cvt_pk_bf16(y0.x, y0.y); w.y = cvt_pk_bf16(y0.z, y0.w); w.z = cvt_pk_bf16(y1.x, y1.y); w.w = cvt_pk_bf16(y1.z, y1.w);
            *(GAS u32x4*)(H + (size_t)row * D + c) = w; }
    }
}

using pg::Unit;
typedef pg::f32x4 (AccT)[2][2][4][2];

struct DenseProb {
    const char* A; const char* Bt; int lda, ldb, K, nM, nN, G, vcu; size_t hstepA, hstepB;
    __device__ __forceinline__ void init(const void* A_, const void* Bt_, int lda_, int ldb_, int K_, int nM_, int nN_, const Frame& F, int Geff = 0) {
        A = (const char*)A_; Bt = (const char*)Bt_; lda = lda_; ldb = ldb_; K = K_; nM = nM_; nN = nN_; G = (Geff > 0 && Geff < F.G) ? Geff : F.G; vcu = F.vcu; hstepA = (size_t)128 * lda * 2; hstepB = (size_t)128 * ldb * 2; }
    __device__ __forceinline__ bool next(int i, Unit& u) const { if (vcu >= G) return false; const int L = i * G + vcu; if (L >= nM * nN) return false; u.pm = L / nN; u.pn = L % nN; u.z = 0; u.aux = 0; u.half = 0; return true; }
    __device__ __forceinline__ const char* a_base(const Unit& u) const { return A + (size_t)u.pm * 256 * lda * 2; }
    __device__ __forceinline__ const char* b_base(const Unit& u) const { return Bt + (size_t)u.pn * 256 * ldb * 2; }
    __device__ __forceinline__ unsigned a_off(int R, int C) const { return (unsigned)(R * lda + C) * 2u; }
    __device__ __forceinline__ unsigned b_off(int R, int C) const { return (unsigned)(R * ldb + C) * 2u; }
    __device__ __forceinline__ unsigned a_row(const Unit&, int) const { return 0u; }
};

template <int LD, int NM, int NN>
struct DenseProbC {
    const char* A; const char* Bt; volatile LAS unsigned* Mz; int K, G, vcu; size_t hstepA, hstepB;
    __device__ __forceinline__ void init(const void* A_, const void* Bt_, const Frame& F, int Geff = 0) {
        A = (const char*)A_; Bt = (const char*)Bt_; Mz = F.MISC + 4; K = LD; G = (Geff > 0 && Geff < F.G) ? Geff : F.G; vcu = F.vcu; hstepA = (size_t)128 * LD * 2; hstepB = (size_t)128 * LD * 2; }
    __device__ __forceinline__ bool next(int i, Unit& u) const { if (vcu >= G) return false; const int L = i * G + vcu + (int)Mz[0]; if (L >= NM * NN) return false; u.pm = L / NN; u.pn = L % NN; u.z = 0; u.aux = 0; u.half = 0; return true; }
    __device__ __forceinline__ const char* a_base(const Unit& u) const { return A + (size_t)u.pm * 256 * LD * 2; }
    __device__ __forceinline__ const char* b_base(const Unit& u) const { return Bt + (size_t)u.pn * 256 * LD * 2; }
    __device__ __forceinline__ unsigned a_off(int R, int C) const { return (unsigned)(R * LD + C) * 2u; }
    __device__ __forceinline__ unsigned b_off(int R, int C) const { return (unsigned)(R * LD + C) * 2u; }
    __device__ __forceinline__ unsigned a_row(const Unit&, int) const { return 0u; }
};

template <bool BASE32>
struct EpiResid {
    static constexpr bool PERM = true;
    bf16* X; const float* bias; const float* gate_lat; const float* gate_ctx; const void* Bl; const void* Bc;
    __device__ __forceinline__ void operator()(const AccT& acc, const Unit& u, int wr, int wc, int fr, int fq) const {
        const int row0 = u.pm * 256 + wr * 64 + fr, col0 = u.pn * 256 + wc * 32 + 8 * fq;
        const bool isctx = (u.pm * 256 >= SEQ);
        const float* gt = isctx ? gate_ctx : gate_lat;
        const float* bs32 = isctx ? (const float*)Bc - (size_t)SEQ * D : (const float*)Bl;
        const bf16* bs16 = isctx ? (const bf16*)Bc - (size_t)SEQ * D : (const bf16*)Bl;
        f32x4 bv[2][2], gv[2][2];
#pragma unroll
        for (int bj = 0; bj < 2; ++bj)
#pragma unroll
            for (int n = 0; n < 2; ++n) { bv[bj][n] = bias ? *(const GAS f32x4*)(bias + col0 + bj * 128 + n * 4) : (f32x4){0.f, 0.f, 0.f, 0.f}; gv[bj][n] = *(const GAS f32x4*)(gt + col0 + bj * 128 + n * 4); }
#pragma unroll
        for (int ai = 0; ai < 2; ++ai)
#pragma unroll
            for (int m = 0; m < 4; ++m) { const size_t off = (size_t)(row0 + ai * 128 + m * 16) * D + col0;
#pragma unroll
                for (int bj = 0; bj < 2; ++bj) { f32x4 b0, b1;
                    if constexpr (BASE32) { b0 = *(const GAS f32x4*)(bs32 + off + bj * 128); b1 = *(const GAS f32x4*)(bs32 + off + bj * 128 + 4); }
                    else { const u32x4 w = *(const GAS u32x4*)(bs16 + off + bj * 128); b0 = (f32x4){bflo(w.x), bfhi(w.x), bflo(w.y), bfhi(w.y)}; b1 = (f32x4){bflo(w.z), bfhi(w.z), bflo(w.w), bfhi(w.w)}; }
                    const f32x4 r0 = b0 + gv[bj][0] * (acc[ai][bj][m][0] + bv[bj][0]), r1 = b1 + gv[bj][1] * (acc[ai][bj][m][1] + bv[bj][1]);
                    u32x4 o; o.x = cvt_pk_bf16(r0.x, r0.y); o.y = cvt_pk_bf16(r0.z, r0.w); o.z = cvt_pk_bf16(r1.x, r1.y); o.w = cvt_pk_bf16(r1.z, r1.w);
                    *(GAS u32x4*)(X + off + bj * 128) = o; } }
    }
};

struct CdftProb {
    const char* DT; const char* H; int K, G, vcu; size_t hstepA, hstepB;
    __device__ __forceinline__ void init(const void* DT_, const void* H_, const Frame& F) { DT = (const char*)DT_; H = (const char*)H_; K = 256; G = F.G; vcu = F.vcu; hstepA = (size_t)128 * 256 * 2; hstepB = (size_t)D * 2; }
    __device__ __forceinline__ bool next(int i, Unit& u) const { const int L = i * G + vcu; if (L >= 16 * 64) return false; u.pm = L / 64; u.pn = L % 64; u.z = 0; u.aux = 0; u.half = 0; return true; }
    __device__ __forceinline__ const char* a_base(const Unit& u) const { return DT + (size_t)(u.pm & 1) * 256 * 256 * 2; }
    __device__ __forceinline__ const char* b_base(const Unit& u) const { return H + (size_t)(2 * u.pn) * D * 2 + (size_t)(u.pm >> 1) * 256 * 2; }
    __device__ __forceinline__ unsigned a_off(int R, int C) const { return (unsigned)(R * 256 + C) * 2u; }
    __device__ __forceinline__ unsigned b_off(int R, int C) const { return (unsigned)((size_t)R * 128 * D + C) * 2u; }
    __device__ __forceinline__ unsigned a_row(const Unit&, int) const { return 0u; }
};
struct EpiCdft {
    static constexpr bool PERM = true;
    bf16* L1;
    __device__ __forceinline__ void operator()(const AccT& acc, const Unit& u, int wr, int wc, int fr, int fq) const {
#pragma unroll
        for (int ai = 0; ai < 2; ++ai)
#pragma unroll
            for (int m = 0; m < 4; ++m) { const int mrow = u.pm * 256 + ai * 128 + wr * 64 + m * 16 + fr;
#pragma unroll
                for (int bj = 0; bj < 2; ++bj) { const f32x4 v0 = acc[ai][bj][m][0], v1 = acc[ai][bj][m][1];
                    u32x4 w; w.x = cvt_pk_bf16(v0[0], v0[1]); w.y = cvt_pk_bf16(v0[2], v0[3]); w.z = cvt_pk_bf16(v1[0], v1[1]); w.w = cvt_pk_bf16(v1[2], v1[3]);
                    *(GAS u32x4*)(L1 + ((size_t)(2 * u.pn + bj) * 4096 + mrow) * 128 + wc * 32 + 8 * fq) = w; } }
    }
};
struct CdftCtxProb {
    const char* DT; const char* H; int K, G, vcu; size_t hstepA, hstepB;
    __device__ __forceinline__ void init(const void* DT_, const void* H_, const Frame& F) { DT = (const char*)DT_; H = (const char*)H_; K = 256; G = F.G; vcu = F.vcu; hstepA = (size_t)128 * 256 * 2; hstepB = (size_t)128 * D * 2; }
    __device__ __forceinline__ bool next(int i, Unit& u) const { const int L = i * G + vcu; if (L >= 16) return false; u.pm = L; u.pn = 0; u.z = 0; u.aux = 0; u.half = 0; return true; }
    __device__ __forceinline__ const char* a_base(const Unit& u) const { return DT + (size_t)(u.pm & 1) * 256 * 256 * 2; }
    __device__ __forceinline__ const char* b_base(const Unit& u) const { return H + (size_t)SEQ * D * 2 + (size_t)(u.pm >> 1) * 256 * 2; }
    __device__ __forceinline__ unsigned a_off(int R, int C) const { return (unsigned)(R * 256 + C) * 2u; }
    __device__ __forceinline__ unsigned b_off(int R, int C) const { return (unsigned)(R * D + C) * 2u; }
    __device__ __forceinline__ unsigned a_row(const Unit&, int) const { return 0u; }
};
struct EpiCdftCtx {
    static constexpr bool PERM = true;
    bf16* LC;
    __device__ __forceinline__ void operator()(const AccT& acc, const Unit& u, int wr, int wc, int fr, int fq) const {
#pragma unroll
        for (int ai = 0; ai < 2; ++ai)
#pragma unroll
            for (int m = 0; m < 4; ++m) { const int mrow = u.pm * 256 + ai * 128 + wr * 64 + m * 16 + fr;
#pragma unroll
                for (int bj = 0; bj < 2; ++bj) { const f32x4 v0 = acc[ai][bj][m][0], v1 = acc[ai][bj][m][1];
                    u32x4 w; w.x = cvt_pk_bf16(v0[0], v0[1]); w.y = cvt_pk_bf16(v0[2], v0[3]); w.z = cvt_pk_bf16(v1[0], v1[1]); w.w = cvt_pk_bf16(v1[2], v1[3]);
                    *(GAS u32x4*)(LC + (size_t)mrow * 256 + bj * 128 + wc * 32 + 8 * fq) = w; } }
    }
};
struct Step1Prob {
    const char* DM1; const char* L1; int K, G, vcu; size_t hstepA, hstepB;
    __device__ __forceinline__ void init(const void* DM1_, const void* L1_, const Frame& F) { DM1 = (const char*)DM1_; L1 = (const char*)L1_; K = 256; G = F.G; vcu = F.vcu; hstepA = (size_t)128 * 256 * 2; hstepB = 512; }
    __device__ __forceinline__ bool next(int i, Unit& u) const { const int L = i * G + vcu; if (L >= 1024) return false; u.pm = 0; u.pn = L; u.z = 0; u.aux = 0; u.half = 0; return true; }
    __device__ __forceinline__ const char* a_base(const Unit&) const { return DM1; }
    __device__ __forceinline__ const char* b_base(const Unit& u) const { return L1 + (size_t)u.pn * 1024; }
    __device__ __forceinline__ unsigned a_off(int R, int C) const { return (unsigned)(R * 256 + C) * 2u; }
    __device__ __forceinline__ unsigned b_off(int R, int C) const { return (unsigned)((size_t)R * 2048 * 256 + C) * 2u; }
    __device__ __forceinline__ unsigned a_row(const Unit&, int) const { return 0u; }
};
struct EpiStep1 {
    static constexpr bool PERM = true;
    bf16* L2;
    __device__ __forceinline__ void operator()(const AccT& acc, const Unit& u, int wr, int wc, int fr, int fq) const {
#pragma unroll
        for (int m = 0; m < 4; ++m) { int p = wr * 64 + m * 16 + fr; asm volatile("" : "+v"(p));
#pragma unroll
            for (int n = 0; n < 2; ++n) {
                float cs[4], sn[4];
#pragma unroll
                for (int e = 0; e < 4; ++e) { const int b = wc * 32 + 8 * fq + 4 * n + e; const float x = (float)(p * b) * (1.f / 16384.f); cs[e] = __builtin_amdgcn_cosf(x); sn[e] = __builtin_amdgcn_sinf(x); }
#pragma unroll
                for (int bj = 0; bj < 2; ++bj) {
                    float yr[4], yi[4];
#pragma unroll
                    for (int e = 0; e < 4; ++e) { const float re = acc[0][bj][m][n][e], im = acc[1][bj][m][n][e]; yr[e] = re * cs[e] + im * sn[e]; yi[e] = im * cs[e] - re * sn[e]; }
                    bf16* dst = L2 + (((size_t)p * 2048 + (2 * u.pn + bj)) * 2) * 128 + wc * 32 + 8 * fq + 4 * n;
                    u32x2 w0, w1; w0.x = cvt_pk_bf16(yr[0], yr[1]); w0.y = cvt_pk_bf16(yr[2], yr[3]); w1.x = cvt_pk_bf16(yi[0], yi[1]); w1.y = cvt_pk_bf16(yi[2], yi[3]);
                    *(GAS u32x2*)dst = w0; *(GAS u32x2*)(dst + 128) = w1; }
                __builtin_amdgcn_sched_barrier(0);
            } }
    }
};
struct Step2Prob {
    const char* DM2; const char* L2; int K, G, vcu; size_t hstepA, hstepB;
    __device__ __forceinline__ void init(const void* DM2_, const void* L2_, const Frame& F) { DM2 = (const char*)DM2_; L2 = (const char*)L2_; K = 256; G = F.G; vcu = F.vcu; hstepA = (size_t)128 * 256 * 2; hstepB = (size_t)128 * 256 * 2; }
    __device__ __forceinline__ bool next(int i, Unit& u) const { const int L = i * G + vcu; if (L >= 1024) return false; u.pm = 0; u.z = L / 8; u.pn = L % 8; u.aux = 0; u.half = 0; return true; }
    __device__ __forceinline__ const char* a_base(const Unit&) const { return DM2; }
    __device__ __forceinline__ const char* b_base(const Unit& u) const { return L2 + ((size_t)u.z * 2048 + (size_t)u.pn * 256) * 256 * 2; }
    __device__ __forceinline__ unsigned a_off(int R, int C) const { return (unsigned)(R * 256 + C) * 2u; }
    __device__ __forceinline__ unsigned b_off(int R, int C) const { return (unsigned)(R * 256 + C) * 2u; }
    __device__ __forceinline__ unsigned a_row(const Unit&, int) const { return 0u; }
};
struct EpiStep2 {
    static constexpr bool PERM = true;
    bf16* Fo; float scale;
    __device__ __forceinline__ void operator()(const AccT& acc, const Unit& u, int wr, int wc, int fr, int fq) const {
#pragma unroll
        for (int m = 0; m < 4; ++m) { const int q = wr * 64 + m * 16 + fr; bf16* rowp = Fo + (size_t)(u.z + 128 * q) * D + u.pn * 256 + wc * 32 + 8 * fq;
#pragma unroll
            for (int bj = 0; bj < 2; ++bj) { const f32x4 v0 = acc[0][bj][m][0] * scale, v1 = acc[0][bj][m][1] * scale;
                u32x4 w; w.x = cvt_pk_bf16(v0[0], v0[1]); w.y = cvt_pk_bf16(v0[2], v0[3]); w.z = cvt_pk_bf16(v1[0], v1[1]); w.w = cvt_pk_bf16(v1[2], v1[3]);
                *(GAS u32x4*)(rowp + bj * 128) = w; } }
    }
};
struct SeqCtxProb {
    const char* DM; const char* LC; int K, G, vcu; size_t hstepA, hstepB;
    __device__ __forceinline__ void init(const void* DM_, const void* LC_, const Frame& F) { DM = (const char*)DM_; LC = (const char*)LC_; K = 512; G = F.G; vcu = F.vcu; hstepA = (size_t)128 * 512 * 2; hstepB = (size_t)128 * 512 * 2; }
    __device__ __forceinline__ bool next(int i, Unit& u) const { const int L = i * G + vcu; if (L >= 8) return false; u.pm = 0; u.pn = L; u.z = 0; u.aux = 0; u.half = 0; return true; }
    __device__ __forceinline__ const char* a_base(const Unit&) const { return DM; }
    __device__ __forceinline__ const char* b_base(const Unit& u) const { return LC + (size_t)u.pn * 256 * 512 * 2; }
    __device__ __forceinline__ unsigned a_off(int R, int C) const { return (unsigned)(R * 512 + C) * 2u; }
    __device__ __forceinline__ unsigned b_off(int R, int C) const { return (unsigned)(R * 512 + C) * 2u; }
    __device__ __forceinline__ unsigned a_row(const Unit&, int) const { return 0u; }
};
struct EpiSeqCtx {
    static constexpr bool PERM = true;
    bf16* Fo;
    __device__ __forceinline__ void operator()(const AccT& acc, const Unit& u, int wr, int wc, int fr, int fq) const {
#pragma unroll
        for (int ai = 0; ai < 2; ++ai)
#pragma unroll
            for (int m = 0; m < 4; ++m) { bf16* rowp = Fo + (size_t)(SEQ + ai * 128 + wr * 64 + m * 16 + fr) * D + u.pn * 256 + wc * 32 + 8 * fq;
#pragma unroll
                for (int bj = 0; bj < 2; ++bj) { const f32x4 v0 = acc[ai][bj][m][0] * (1.f / 256.f), v1 = acc[ai][bj][m][1] * (1.f / 256.f);
                    u32x4 w; w.x = cvt_pk_bf16(v0[0], v0[1]); w.y = cvt_pk_bf16(v0[2], v0[3]); w.z = cvt_pk_bf16(v1[0], v1[1]); w.w = cvt_pk_bf16(v1[2], v1[3]);
                    *(GAS u32x4*)(rowp + bj * 128) = w; } }
    }
};
}
namespace mk {
template <int XR = 0>
__device__ __forceinline__ void router_phase(Frame& F, const bf16* X, const float* g, const float* modl, const float* wr_, const float* br_, bf16* H2,
                                             unsigned* cnt, int* tokl, int* rec, float* gates, int nrows) {
    constexpr int RB_LD = 32 * 68;
    LAS float* rowbuf = (LAS float*)F.lds; LAS float* partial = (LAS float*)(F.lds + 69632); LAS float* gtab = (LAS float*)(F.lds + 102400);
    const int e4 = F.lane & 7, ks8 = F.wave * 8 + (F.lane >> 3);
    LAS unsigned* lcnt = (LAS unsigned*)(F.lds + 135168); LAS unsigned* lbase = lcnt + 32; LAS unsigned* lpick = lcnt + 64;
    __syncthreads();
    if (F.tid < 32) lcnt[F.tid] = 0u;
    lpick[F.tid] = 0xffffffffu;
    { float gv[8], scv[8], shv[8];
#pragma unroll
      for (int q = 0; q < 8; ++q) { const int i = F.tid + q * NTHR, w = i >> 11, c = i & (D - 1); const float* m = modl + (size_t)w * 6 * D + (size_t)3 * D; gv[q] = g[c]; scv[q] = m[D + c]; shv[q] = m[c]; }
#pragma unroll
      for (int q = 0; q < 8; ++q) { const int i = F.tid + q * NTHR, w = i >> 11, c = i & (D - 1); gtab[(w * 2 + 0) * D + c] = gv[q] * (1.f + scv[q]); gtab[(w * 2 + 1) * D + c] = shv[q]; } }
    f32x4 wq[32];
#pragma unroll
    for (int i = 0; i < 32; ++i) wq[i] = *(const GAS f32x4*)(wr_ + (size_t)(ks8 * 32 + i) * NE + 4 * e4);
    const float bias = br_[F.lane & 31];
    const int niter = (nrows + 7) / 8;
    f32x4 v[8];
    int it = F.vcu;
    { const int row = it * 8 + F.wave; if (it < niter && row < nrows) { const GAS u32x2* xr = (const GAS u32x2*)(X + (size_t)row * D) + F.lane;
#pragma unroll
        for (int j = 0; j < 8; ++j) { const u32x2 w = xr[64 * j]; v[j] = (f32x4){bflo(w.x), bfhi(w.x), bflo(w.y), bfhi(w.y)}; } } }
    int itl = 0;
    __syncthreads();
    for (; it < niter; it += F.G, ++itl) {
        const int row = it * 8 + F.wave; const bool act = row < nrows;
        if (act) {
            const LAS float* gt = gtab + (row >= SEQ ? 2 * D : 0);
            float s = 0.f;
#pragma unroll
            for (int j = 0; j < 8; ++j) s += (v[j].x * v[j].x + v[j].y * v[j].y) + (v[j].z * v[j].z + v[j].w * v[j].w);
            const float r = rsqrtf(wave_sum(s) * (1.f / D) + 1e-6f);
            GAS u32x2* o = (GAS u32x2*)(H2 + (size_t)row * D) + F.lane;
#pragma unroll
            for (int j = 0; j < 8; ++j) {
                const f32x4 gg = *(const LAS f32x4*)(gt + 4 * (F.lane + 64 * j)), sh = *(const LAS f32x4*)(gt + D + 4 * (F.lane + 64 * j));
                const f32x4 y = v[j] * r * gg + sh;
                if constexpr (MOE_FP8) { int w8 = __builtin_amdgcn_cvt_pk_fp8_f32(y.x, y.y, 0, false); w8 = __builtin_amdgcn_cvt_pk_fp8_f32(y.z, y.w, w8, true); *((GAS unsigned*)((unsigned char*)H2 + (size_t)row * D) + F.lane + 64 * j) = (unsigned)w8; }
                else { u32x2 w; w.x = cvt_pk_bf16(y.x, y.y); w.y = cvt_pk_bf16(y.z, y.w); o[64 * j] = w; }
                { const int c = 4 * (F.lane + 64 * j); *(LAS f32x4*)(rowbuf + F.wave * RB_LD + (c >> 6) * 68 + (c & 63)) = y; }
            }
        }
        { const int nrow = (it + F.G) * 8 + F.wave; if (it + F.G < niter && nrow < nrows) { const GAS u32x2* xr = (const GAS u32x2*)(X + (size_t)nrow * D) + F.lane;
#pragma unroll
            for (int j = 0; j < 8; ++j) { const u32x2 w = xr[64 * j]; v[j] = (f32x4){bflo(w.x), bfhi(w.x), bflo(w.y), bfhi(w.y)}; } } }
        __syncthreads();
#pragma unroll 1
        for (int rr = 0; rr < ((XR & 1) ? 0 : 8); ++rr) {
            const LAS f32x4* xb = (const LAS f32x4*)(rowbuf + rr * RB_LD + (ks8 >> 1) * 68 + 32 * (ks8 & 1));
            f32x4 a0 = (f32x4){0.f, 0.f, 0.f, 0.f}, a1 = (f32x4){0.f, 0.f, 0.f, 0.f};
#pragma unroll
            for (int i = 0; i < 8; ++i) { const f32x4 xv = xb[i]; a0 += xv.x * wq[4 * i]; a1 += xv.y * wq[4 * i + 1]; a0 += xv.z * wq[4 * i + 2]; a1 += xv.w * wq[4 * i + 3]; }
            f32x4 a = a0 + a1;
#pragma unroll
            for (int e = 0; e < 4; ++e) { float t = a[e]; t += dpp_get<0x128>(t); t += __int_as_float(__builtin_amdgcn_ds_swizzle(__float_as_int(t), 0x401f));
                { const auto rr2 = __builtin_amdgcn_permlane32_swap(__float_as_uint(t), __float_as_uint(t), false, false); t = __uint_as_float(rr2[0]) + __uint_as_float(rr2[1]); } a[e] = t; }
            if (F.lane < 8) *(LAS f32x4*)(partial + (rr * 8 + F.wave) * 32 + 4 * e4) = a;
        }
        __syncthreads();
        if (act && !(XR & 2)) {
            LAS float* lgb = partial + 2048 + F.wave * 64;
            float lg = bias;
            if (F.lane < 32) {
#pragma unroll
                for (int k2 = 0; k2 < 8; ++k2) lg += partial[(F.wave * 8 + k2) * 32 + F.lane]; }
            asm volatile("s_waitcnt lgkmcnt(0)" ::: "memory");
            if (F.lane < 32) lgb[F.lane] = lg;
            asm volatile("s_waitcnt lgkmcnt(0)" ::: "memory");
            int rank = 0;
#pragma unroll 1
            for (int q4 = 0; q4 < 8; ++q4) { const f32x4 o = *(const LAS f32x4*)(lgb + 4 * q4); const int e0 = 4 * q4;
                rank += (o.x > lg || (o.x == lg && e0 + 0 < F.lane)) ? 1 : 0; rank += (o.y > lg || (o.y == lg && e0 + 1 < F.lane)) ? 1 : 0;
                rank += (o.z > lg || (o.z == lg && e0 + 2 < F.lane)) ? 1 : 0; rank += (o.w > lg || (o.w == lg && e0 + 3 < F.lane)) ? 1 : 0; }
            if (F.lane < 32 && rank < 4) { ((LAS int*)lgb)[32 + rank] = F.lane; lgb[36 + rank] = lg; }
            asm volatile("s_waitcnt lgkmcnt(0)" ::: "memory");
            const f32x4 tvv = *(const LAS f32x4*)(lgb + 36); const int myk = F.lane & 3;
            const float e1 = __expf(tvv.y - tvv.x), e2x = __expf(tvv.z - tvv.x), e3 = __expf(tvv.w - tvv.x);
            const float inv = 1.f / (1.f + e1 + e2x + e3);
            if (F.lane < 4) {
                const int ee = ((const LAS int*)lgb)[32 + myk]; const float gv = ((myk == 0) ? 1.f : (myk == 1) ? e1 : (myk == 2) ? e2x : e3) * inv;
                if (itl < 16) { const unsigned lp = __hip_atomic_fetch_add(&lcnt[ee], 1u, __ATOMIC_RELAXED, __HIP_MEMORY_SCOPE_WORKGROUP); lpick[(itl * 8 + F.wave) * 4 + myk] = (unsigned)ee | (lp << 8); }
                else { const int pos = (int)atomicAdd(&cnt[ee * 64], 1u); tokl[ee * CAP + pos] = row; rec[(row * 4 + myk) * 2 + 1] = pos; }
                rec[(row * 4 + myk) * 2] = ee; gates[row * 4 + myk] = gv;
            }
        }
    }
    __syncthreads();
    if (F.tid < 32) { const unsigned c = lcnt[F.tid]; lbase[F.tid] = c ? atomicAdd(&cnt[F.tid * 64], c) : 0u; }
    __syncthreads();
    { const unsigned pv = lpick[F.tid];
      if (pv != 0xffffffffu) { const int e = (int)(pv & 255u), k = F.tid & 3, wv = (F.tid >> 2) & 7, il = F.tid >> 5; const int row = (F.vcu + il * F.G) * 8 + wv; const int pos = (int)(lbase[e] + (pv >> 8));
          tokl[e * CAP + pos] = row; rec[(row * 4 + k) * 2 + 1] = pos; } }
}

__device__ __forceinline__ void moe_tables(Frame& F, const unsigned* cnt) {
    volatile LAS unsigned* tb = F.MISC + 64; volatile LAS unsigned* cn = F.MISC + 128; volatile LAS unsigned* hf = F.MISC + 192; volatile LAS unsigned* tf = F.MISC + 256; volatile LAS unsigned* th = F.MISC + 320;
    if (F.wave == 0) {
        const int e = F.lane & 31;
        const unsigned c = __hip_atomic_load(cnt + e * 64, __ATOMIC_RELAXED, __HIP_MEMORY_SCOPE_AGENT);
        const unsigned nt = (c + 255u) / 256u, h = ((c & 255u) != 0u && (c & 255u) <= 128u) ? 1u : 0u, nf = nt - h;
        unsigned inc = nt, incf = nf, inch = h;
#pragma unroll
        for (int o = 1; o < 32; o <<= 1) { const unsigned v = __shfl_up(inc, o, 32), vf = __shfl_up(incf, o, 32), vh = __shfl_up(inch, o, 32); if (e >= o) { inc += v; incf += vf; inch += vh; } }
        if (F.lane < 32) { tb[e] = inc - nt; cn[e] = c; hf[e] = h; tf[e] = incf - nf; th[e] = inch - h; if (e == 31) { tb[NE] = inc; tf[NE] = incf; th[NE] = inch; } }
    }
    __syncthreads();
}
__device__ __forceinline__ bool moe_unit(const volatile LAS unsigned* MISC, int L, Unit& u) {
    const volatile LAS unsigned* tb = MISC + 64; const volatile LAS unsigned* tf = MISC + 256; const volatile LAS unsigned* th = MISC + 320;
    const int tt = L >> 3, nfull = (int)tf[NE]; if (tt >= (int)tb[NE]) return false;
    const int j = (int)(threadIdx.x & 31);
    int e, mt;
    if (tt < nfull) { const unsigned long long bm = __ballot((int)tf[j] <= tt); e = __popc((unsigned)bm) - 1; mt = tt - (int)tf[e]; u.half = 0; }
    else { const int hh = tt - nfull; const unsigned long long bm = __ballot((int)th[j] <= hh); e = __popc((unsigned)bm) - 1; mt = (int)(tb[e + 1] - tb[e]) - 1; u.half = 1; }
    u.pm = (int)tb[e] + mt; u.pn = L & 7; u.z = e; u.aux = mt; return true;
}
struct Moe1Prob {
    const char* H2; const char* W1; const int* tokl; volatile LAS unsigned* MISCp; volatile LAS unsigned* cn; int K, G, vcu; size_t hstepA, hstepB;
    __device__ __forceinline__ void init(const void* H2_, const void* W1_, const int* tokl_, const Frame& F) { H2 = (const char*)H2_; W1 = (const char*)W1_; tokl = tokl_; MISCp = F.MISC; cn = F.MISC + 128; K = D * MOE_EB / 2; G = F.G; vcu = F.vcu; hstepA = 0; hstepB = (size_t)128 * D * MOE_EB; }
    __device__ __forceinline__ bool next(int i, Unit& u) const { return moe_unit(MISCp, i * G + vcu, u); }
    __device__ __forceinline__ const char* a_base(const Unit&) const { return H2; }
    __device__ __forceinline__ const char* b_base(const Unit& u) const { return W1 + ((size_t)u.z * 2048 + (size_t)u.pn * 256) * D * MOE_EB; }
    __device__ __forceinline__ unsigned a_off(int, int) const { return 0u; }
    __device__ __forceinline__ unsigned b_off(int R, int C) const { return (unsigned)(R * D * MOE_EB + C * 2); }
    __device__ __forceinline__ unsigned a_row(const Unit& u, int r) const { const int idx = u.aux * 256 + r; const int tok = (idx < (int)cn[u.z]) ? tokl[u.z * CAP + idx] : 0; return (unsigned)tok * (unsigned)(D * MOE_EB); }
};
#ifdef MK_EXP
struct Moe1ProbHot : Moe1Prob {
    __device__ __forceinline__ const char* b_base(const Unit&) const { return W1; }
    __device__ __forceinline__ unsigned a_row(const Unit&, int r) const { return (unsigned)r * (unsigned)(D * MOE_EB); }
};
#endif
struct EpiMoe1 {
    static constexpr bool PERM = true;
    bf16* ACT; const float* b1;
    __device__ __forceinline__ void operator()(const AccT& acc, const Unit& u, int wr, int wc, int fr, int fq) const {
        const int j0 = wc * 32 + 8 * fq; const float* bg = b1 + (size_t)u.z * 2 * DE + u.pn * 128 + j0; const float* bl = bg + DE;
        f32x4 bgv[2], blv[2];
#pragma unroll
        for (int n = 0; n < 2; ++n) { bgv[n] = *(const GAS f32x4*)(bg + 4 * n); blv[n] = *(const GAS f32x4*)(bl + 4 * n); }
#pragma unroll
        for (int ai = 0; ai < 2; ++ai) { if (ai == 1 && u.half) break;
#pragma unroll
            for (int m = 0; m < 4; ++m) { const int r = ai * 128 + wr * 64 + m * 16 + fr;
                float o[8];
#pragma unroll
                for (int n = 0; n < 2; ++n)
#pragma unroll
                    for (int e = 0; e < 4; ++e) { float gt = acc[ai][0][m][n][e] * (1.f / MOE_WSCALE) + bgv[n][e], ln = acc[ai][1][m][n][e] * (1.f / MOE_WSCALE) + blv[n][e];
                        gt = fminf(gt, 7.f); ln = fminf(fmaxf(ln, -7.f), 7.f); o[4 * n + e] = (ln + 1.f) * gt * sigm_f(1.702f * gt); }
                if constexpr (MOE_FP8) { int w0 = __builtin_amdgcn_cvt_pk_fp8_f32(o[0], o[1], 0, false); w0 = __builtin_amdgcn_cvt_pk_fp8_f32(o[2], o[3], w0, true); int w1 = __builtin_amdgcn_cvt_pk_fp8_f32(o[4], o[5], 0, false); w1 = __builtin_amdgcn_cvt_pk_fp8_f32(o[6], o[7], w1, true);
                    *(GAS u32x2*)((unsigned char*)ACT + (size_t)(u.pm * 256 + r) * DE + u.pn * 128 + j0) = (u32x2){(unsigned)w0, (unsigned)w1}; }
                else { u32x4 w; w.x = cvt_pk_bf16(o[0], o[1]); w.y = cvt_pk_bf16(o[2], o[3]); w.z = cvt_pk_bf16(o[4], o[5]); w.w = cvt_pk_bf16(o[6], o[7]);
                    *(GAS u32x4*)(ACT + (size_t)(u.pm * 256 + r) * DE + u.pn * 128 + j0) = w; } } }
    }
};
struct Moe2Prob {
    const char* ACT; const char* W2; volatile LAS unsigned* MISCp; int K, G, vcu; size_t hstepA, hstepB;
    __device__ __forceinline__ void init(const void* ACT_, const void* W2_, const Frame& F) { ACT = (const char*)ACT_; W2 = (const char*)W2_; MISCp = F.MISC; K = DE * MOE_EB / 2; G = F.G; vcu = F.vcu; hstepA = (size_t)128 * DE * MOE_EB; hstepB = (size_t)128 * DE * MOE_EB; }
    __device__ __forceinline__ bool next(int i, Unit& u) const { return moe_unit(MISCp, i * G + vcu, u); }
    __device__ __forceinline__ const char* a_base(const Unit& u) const { return ACT + (size_t)u.pm * 256 * DE * MOE_EB; }
    __device__ __forceinline__ const char* b_base(const Unit& u) const { return W2 + ((size_t)u.z * D + (size_t)u.pn * 256) * DE * MOE_EB; }
    __device__ __forceinline__ unsigned a_off(int R, int C) const { return (unsigned)(R * DE * MOE_EB + C * 2); }
    __device__ __forceinline__ unsigned b_off(int R, int C) const { return (unsigned)(R * DE * MOE_EB + C * 2); }
    __device__ __forceinline__ unsigned a_row(const Unit&, int) const { return 0u; }
};
struct EpiMoe2 {
    static constexpr bool PERM = true;
    bf16* YB; const float* b2;
    __device__ __forceinline__ void operator()(const AccT& acc, const Unit& u, int wr, int wc, int fr, int fq) const {
        const int c0 = u.pn * 256 + wc * 32 + 8 * fq; const float* bb = b2 + (size_t)u.z * D + c0;
        f32x4 bv[2][2];
#pragma unroll
        for (int bj = 0; bj < 2; ++bj)
#pragma unroll
            for (int n = 0; n < 2; ++n) bv[bj][n] = *(const GAS f32x4*)(bb + bj * 128 + 4 * n);
#pragma unroll
        for (int ai = 0; ai < 2; ++ai) { if (ai == 1 && u.half) break;
#pragma unroll
            for (int m = 0; m < 4; ++m) { bf16* rowp = YB + (size_t)(u.pm * 256 + ai * 128 + wr * 64 + m * 16 + fr) * D + c0;
#pragma unroll
                for (int bj = 0; bj < 2; ++bj) { const f32x4 v0 = acc[ai][bj][m][0] * (1.f / MOE_WSCALE) + bv[bj][0], v1 = acc[ai][bj][m][1] * (1.f / MOE_WSCALE) + bv[bj][1];
                    if constexpr (MOE_FP8) { int w0 = __builtin_amdgcn_cvt_pk_fp8_f32(v0[0], v0[1], 0, false); w0 = __builtin_amdgcn_cvt_pk_fp8_f32(v0[2], v0[3], w0, true); int w1 = __builtin_amdgcn_cvt_pk_fp8_f32(v1[0], v1[1], 0, false); w1 = __builtin_amdgcn_cvt_pk_fp8_f32(v1[2], v1[3], w1, true);
                        *(GAS u32x2*)((unsigned char*)YB + ((size_t)(u.pm * 256 + ai * 128 + wr * 64 + m * 16 + fr) * D + c0 + bj * 128)) = (u32x2){(unsigned)w0, (unsigned)w1}; }
                    else { u32x4 w; w.x = cvt_pk_bf16(v0[0], v0[1]); w.y = cvt_pk_bf16(v0[2], v0[3]); w.z = cvt_pk_bf16(v1[0], v1[1]); w.w = cvt_pk_bf16(v1[2], v1[3]);
                        *(GAS u32x4*)(rowp + bj * 128) = w; } } } }
    }
};
template <bool LAST, bool H8 = false>
__device__ __forceinline__ void combine_phase(Frame& F, bf16* X, const bf16* YB, const int* rec, const float* gates, const float* modl, int nrows, float* out,
                                              const float* gn, const float* modn, bf16* H) {
    volatile LAS unsigned* tb = F.MISC + 64;
    for (int row = F.gw; row < nrows; row += F.NGW) {
        const int isc = row >= SEQ ? 1 : 0;
        const float* g2 = modl + (size_t)isc * 6 * D + (size_t)5 * D;
        int ridx[4]; float gv[4];
#pragma unroll
        for (int k = 0; k < 4; ++k) { const int e = rec[(row * 4 + k) * 2], pos = rec[(row * 4 + k) * 2 + 1]; ridx[k] = 256 * (int)tb[e] + pos; gv[k] = gates[row * 4 + k]; }
        u32x4 yb[4][4]; f32x4 v[8], gg[8];
#pragma unroll
        for (int j = 0; j < 4; ++j) { const int c = 8 * (F.lane + 64 * j);
#pragma unroll
            for (int k = 0; k < 4; ++k) { if constexpr (MOE_FP8) { const u32x2 q8 = __builtin_nontemporal_load((const GAS u32x2*)((const unsigned char*)YB + (size_t)ridx[k] * D + c)); yb[j][k] = (u32x4){q8.x, q8.y, 0u, 0u}; } else yb[j][k] = *(const GAS u32x4*)(YB + (size_t)ridx[k] * D + c); }
            { const u32x4 w = *(const GAS u32x4*)(X + (size_t)row * D + c); v[2 * j] = (f32x4){bflo(w.x), bfhi(w.x), bflo(w.y), bfhi(w.y)}; v[2 * j + 1] = (f32x4){bflo(w.z), bfhi(w.z), bflo(w.w), bfhi(w.w)}; }
            gg[2 * j] = *(const GAS f32x4*)(g2 + c); gg[2 * j + 1] = *(const GAS f32x4*)(g2 + c + 4); }
#pragma unroll
        for (int j = 0; j < 4; ++j) {
            f32x4 s0 = (f32x4){0.f, 0.f, 0.f, 0.f}, s1 = (f32x4){0.f, 0.f, 0.f, 0.f};
#pragma unroll
            for (int k = 0; k < 4; ++k) { const u32x4 w = yb[j][k];
                if constexpr (MOE_FP8) { const f32x2 a0 = __builtin_amdgcn_cvt_pk_f32_fp8((int)w.x, false), a1 = __builtin_amdgcn_cvt_pk_f32_fp8((int)w.x, true), a2 = __builtin_amdgcn_cvt_pk_f32_fp8((int)w.y, false), a3 = __builtin_amdgcn_cvt_pk_f32_fp8((int)w.y, true);
                    s0 += gv[k] * (f32x4){a0.x, a0.y, a1.x, a1.y}; s1 += gv[k] * (f32x4){a2.x, a2.y, a3.x, a3.y}; }
                else { s0 += gv[k] * (f32x4){bflo(w.x), bfhi(w.x), bflo(w.y), bfhi(w.y)}; s1 += gv[k] * (f32x4){bflo(w.z), bfhi(w.z), bflo(w.w), bfhi(w.w)}; } }
            v[2 * j] = v[2 * j] + gg[2 * j] * s0; v[2 * j + 1] = v[2 * j + 1] + gg[2 * j + 1] * s1;
        }
        if (!LAST) {
            const float* m = modn + (size_t)isc * 6 * D;
            f32x4 sh[8], sc[8];
#pragma unroll
            for (int j = 0; j < 4; ++j) { const int c = 8 * (F.lane + 64 * j);
                gg[2 * j] = *(const GAS f32x4*)(gn + c); gg[2 * j + 1] = *(const GAS f32x4*)(gn + c + 4); sh[2 * j] = *(const GAS f32x4*)(m + c); sh[2 * j + 1] = *(const GAS f32x4*)(m + c + 4);
                sc[2 * j] = *(const GAS f32x4*)(m + D + c); sc[2 * j + 1] = *(const GAS f32x4*)(m + D + c + 4); }
            float s = 0.f;
#pragma unroll
            for (int j = 0; j < 8; ++j) s += (v[j].x * v[j].x + v[j].y * v[j].y) + (v[j].z * v[j].z + v[j].w * v[j].w);
            const float r = rsqrtf(wave_sum(s) * (1.f / D) + 1e-6f);
#pragma unroll
            for (int j = 0; j < 4; ++j) { const int c = 8 * (F.lane + 64 * j);
                { u32x4 w; w.x = cvt_pk_bf16(v[2 * j].x, v[2 * j].y); w.y = cvt_pk_bf16(v[2 * j].z, v[2 * j].w); w.z = cvt_pk_bf16(v[2 * j + 1].x, v[2 * j + 1].y); w.w = cvt_pk_bf16(v[2 * j + 1].z, v[2 * j + 1].w); *(GAS u32x4*)(X + (size_t)row * D + c) = w; }
                const f32x4 y0 = v[2 * j] * r * gg[2 * j] * (sc[2 * j] + 1.f) + sh[2 * j], y1 = v[2 * j + 1] * r * gg[2 * j + 1] * (sc[2 * j + 1] + 1.f) + sh[2 * j + 1];
                if constexpr (H8) { int w0 = __builtin_amdgcn_cvt_pk_fp8_f32(y0.x, y0.y, 0, false); w0 = __builtin_amdgcn_cvt_pk_fp8_f32(y0.z, y0.w, w0, true); int w1 = __builtin_amdgcn_cvt_pk_fp8_f32(y1.x, y1.y, 0, false); w1 = __builtin_amdgcn_cvt_pk_fp8_f32(y1.z, y1.w, w1, true);
                    *(GAS u32x2*)((unsigned char*)H + (size_t)row * D + c) = (u32x2){(unsigned)w0, (unsigned)w1}; }
                else { u32x4 w; w.x = cvt_pk_bf16(y0.x, y0.y); w.y = cvt_pk_bf16(y0.z, y0.w); w.z = cvt_pk_bf16(y1.x, y1.y); w.w = cvt_pk_bf16(y1.z, y1.w);
                    *(GAS u32x4*)(H + (size_t)row * D + c) = w; } }
        } else {
#pragma unroll
            for (int j = 0; j < 4; ++j) { const int c = 8 * (F.lane + 64 * j);
                *(GAS f32x4*)(out + (size_t)row * D + c) = v[2 * j]; *(GAS f32x4*)(out + (size_t)row * D + c + 4) = v[2 * j + 1]; }
        }
    }
}
}
namespace mk {
struct EpiConvIn {
    static constexpr bool PERM = true;
    bf16* GB; bf16* S; float sc;
    __device__ __forceinline__ void operator()(const AccT& acc, const Unit& u, int wr, int wc, int fr, int fq) const {
        const int j0 = wc * 32 + 8 * fq;
#pragma unroll
        for (int ai = 0; ai < 2; ++ai)
#pragma unroll
            for (int m = 0; m < 4; ++m) { const size_t row = (size_t)u.pm * 256 + ai * 128 + wr * 64 + m * 16 + fr;
                if (u.pn < 8) {
#pragma unroll
                    for (int bj = 0; bj < 2; ++bj) { const f32x4 v0 = acc[ai][bj][m][0] * sc, v1 = acc[ai][bj][m][1] * sc;
                        u32x4 w; w.x = cvt_pk_bf16(v0[0], v0[1]); w.y = cvt_pk_bf16(v0[2], v0[3]); w.z = cvt_pk_bf16(v1[0], v1[1]); w.w = cvt_pk_bf16(v1[2], v1[3]);
                        *(GAS u32x4*)(GB + row * D + u.pn * 256 + bj * 128 + j0) = w; }
                } else {
                    const f32x4 v0 = acc[ai][0][m][0] * acc[ai][1][m][0] * (sc * sc), v1 = acc[ai][0][m][1] * acc[ai][1][m][1] * (sc * sc);
                    u32x4 w; w.x = cvt_pk_bf16(v0[0], v0[1]); w.y = cvt_pk_bf16(v0[2], v0[3]); w.z = cvt_pk_bf16(v1[0], v1[1]); w.w = cvt_pk_bf16(v1[2], v1[3]);
                    *(GAS u32x4*)(S + row * D + (u.pn - 8) * 128 + j0) = w;
                } }
    }
};
__device__ __forceinline__ void conv_phase(Frame& F, const bf16* GB, const bf16* S, const float* ck, const float* cb, bf16* A2) {
    const int gt = F.gw * 64 + F.lane, c8 = (gt & 255) * 8, r0 = gt >> 8, rstep = (F.NGW * 64) >> 8;
    float kk[3][8], bb[8];
#pragma unroll
    for (int w = 0; w < 3; ++w) { const f32x4 a = *(const GAS f32x4*)(ck + w * D + c8), b = *(const GAS f32x4*)(ck + w * D + c8 + 4); kk[w][0] = a.x; kk[w][1] = a.y; kk[w][2] = a.z; kk[w][3] = a.w; kk[w][4] = b.x; kk[w][5] = b.y; kk[w][6] = b.z; kk[w][7] = b.w; }
    { const f32x4 a = *(const GAS f32x4*)(cb + c8), b = *(const GAS f32x4*)(cb + c8 + 4); bb[0] = a.x; bb[1] = a.y; bb[2] = a.z; bb[3] = a.w; bb[4] = b.x; bb[5] = b.y; bb[6] = b.z; bb[7] = b.w; }
    for (int t0 = r0; t0 < T; t0 += 4 * rstep) {
        u32x4 sv[4][3], gv[4];
#pragma unroll
        for (int i = 0; i < 4; ++i) { const int t = t0 + i * rstep; const int tc = t < T ? t : T - 1; const int lo = tc < SEQ ? 0 : SEQ, hi = tc < SEQ ? SEQ : T;
#pragma unroll
            for (int w = 0; w < 3; ++w) { const int tt = tc + w - 1; const int tl = tt < lo ? lo : (tt >= hi ? hi - 1 : tt); sv[i][w] = *(const GAS u32x4*)(S + (size_t)tl * D + c8); }
            gv[i] = __builtin_nontemporal_load((const GAS u32x4*)(GB + (size_t)tc * D + c8)); }
#pragma unroll
        for (int i = 0; i < 4; ++i) { const int t = t0 + i * rstep; if (t >= T) break; const int lo = t < SEQ ? 0 : SEQ, hi = t < SEQ ? SEQ : T;
            float z[8];
#pragma unroll
            for (int e = 0; e < 8; ++e) z[e] = bb[e];
#pragma unroll
            for (int w = 0; w < 3; ++w) { const int tt = t + w - 1; const float on = (tt >= lo && tt < hi) ? 1.f : 0.f; const u32x4 x = sv[i][w];
                z[0] += on * kk[w][0] * bflo(x.x); z[1] += on * kk[w][1] * bfhi(x.x); z[2] += on * kk[w][2] * bflo(x.y); z[3] += on * kk[w][3] * bfhi(x.y);
                z[4] += on * kk[w][4] * bflo(x.z); z[5] += on * kk[w][5] * bfhi(x.z); z[6] += on * kk[w][6] * bflo(x.w); z[7] += on * kk[w][7] * bfhi(x.w); }
            const u32x4 gq = gv[i];
            u32x4 o; o.x = cvt_pk_bf16(z[0] * bflo(gq.x), z[1] * bfhi(gq.x)); o.y = cvt_pk_bf16(z[2] * bflo(gq.y), z[3] * bfhi(gq.y));
            o.z = cvt_pk_bf16(z[4] * bflo(gq.z), z[5] * bfhi(gq.z)); o.w = cvt_pk_bf16(z[6] * bflo(gq.w), z[7] * bfhi(gq.w));
            *(GAS u32x4*)(A2 + (size_t)t * D + c8) = o; }
    }
}
struct EpiQKV {
    static constexpr bool PERM = true;
    bf16* QR; bf16* KR; bf16* VR; float sc;
    __device__ __forceinline__ void operator()(const AccT& acc, const Unit& u, int wr, int wc, int fr, int fq) const {
        bf16* base; int ld, c0;
        if (u.pn < 8) { base = QR; ld = 2048; c0 = u.pn * 256; } else if (u.pn < 10) { base = KR; ld = 512; c0 = (u.pn - 8) * 256; } else { base = VR; ld = 512; c0 = (u.pn - 10) * 256; }
        c0 += wc * 32 + 8 * fq;
#pragma unroll
        for (int ai = 0; ai < 2; ++ai)
#pragma unroll
            for (int m = 0; m < 4; ++m) { bf16* rowp = base + ((size_t)u.pm * 256 + ai * 128 + wr * 64 + m * 16 + fr) * ld + c0;
#pragma unroll
                for (int bj = 0; bj < 2; ++bj) { const f32x4 v0 = acc[ai][bj][m][0] * sc, v1 = acc[ai][bj][m][1] * sc;
                    u32x4 w; w.x = cvt_pk_bf16(v0[0], v0[1]); w.y = cvt_pk_bf16(v0[2], v0[3]); w.z = cvt_pk_bf16(v1[0], v1[1]); w.w = cvt_pk_bf16(v1[2], v1[3]);
                    *(GAS u32x4*)(rowp + bj * 128) = w; } }
    }
};
__device__ __forceinline__ void qkv_prep_phase(Frame& F, const bf16* QR, const bf16* KR, const bf16* VR, const float* qg, const float* kg, bf16* QB, bf16* KB, bf16* VB, unsigned char* V8T) {
    const int sub = F.lane >> 4, l16 = F.lane & 15, e0 = l16 * 8;
    float inv[8];
#pragma unroll
    for (int e = 0; e < 8; ++e) inv[e] = __expf(-(float)((e0 + e) & 31) * (9.210340371976184f / 32.f));
    float gq[8], gk[8];
#pragma unroll
    for (int e = 0; e < 8; ++e) { gq[e] = qg[e0 + e] * (ATT_PV8 ? att::QK_FOLD : 1.f); gk[e] = kg[e0 + e] * (ATT_PV8 ? att::QK_FOLD : 1.f); }
    const int ngrp = ATT_PV8 ? 5 : 6;
    for (int w0 = F.gw; w0 < T * ngrp; w0 += 2 * F.NGW) {
        u32x4 xin[2];
#pragma unroll
        for (int i = 0; i < 2; ++i) { int w = w0 + i * F.NGW; if (w >= T * ngrp) w = T * ngrp - 1; const int row = w / ngrp, slot = (w % ngrp) * 4 + sub;
            const bf16* src = slot < 16 ? QR + (size_t)row * 2048 + slot * 128 : slot < 20 ? KR + (size_t)row * 512 + (slot - 16) * 128 : VR + (size_t)row * 512 + (slot - 20) * 128;
            xin[i] = __builtin_nontemporal_load((const GAS u32x4*)(src + e0)); }
#pragma unroll
        for (int i = 0; i < 2; ++i) { const int w = w0 + i * F.NGW; if (w >= T * ngrp) break; const int row = w / ngrp, slot = (w % ngrp) * 4 + sub;
            bf16* dst = slot < 16 ? QB + (size_t)row * 2048 + slot * 128 : slot < 20 ? KB + (size_t)row * 512 + (slot - 16) * 128 : VB + (size_t)row * 512 + (slot - 20) * 128;
            float x[8] = {bflo(xin[i].x), bfhi(xin[i].x), bflo(xin[i].y), bfhi(xin[i].y), bflo(xin[i].z), bfhi(xin[i].z), bflo(xin[i].w), bfhi(xin[i].w)};
            if (slot < 20) {
                float s = 0.f;
#pragma unroll
                for (int e = 0; e < 8; ++e) s += x[e] * x[e];
                s += dpp_get<0xB1>(s); s += dpp_get<0x4E>(s); s += dpp_get<0x124>(s); s += dpp_get<0x128>(s);
                const float r = rsqrtf(s * (1.f / 128.f) + 1e-6f);
#pragma unroll
                for (int e = 0; e < 8; ++e) x[e] = x[e] * r * (slot < 16 ? gq[e] : gk[e]);
                if (row < SEQ) {
                    const float pos = (l16 & 4) ? (float)(row & 63) : (float)(row >> 6);
#pragma unroll
                    for (int e = 0; e < 8; ++e) { const float other = dpp_get<0x128>(x[e]);        float sn, cs; __sincosf(pos * inv[e], &sn, &cs);
                        x[e] = (l16 & 8) ? (x[e] * cs + other * sn) : (x[e] * cs - other * sn); }
                }
            }
            if (ATT_FP8 && slot < 20) {
                unsigned char* d8 = slot < 16 ? (unsigned char*)QB + (size_t)row * 2048 + slot * 128 : (unsigned char*)KB + (size_t)row * 512 + (slot - 16) * 128;
                int w0 = __builtin_amdgcn_cvt_pk_fp8_f32(x[0], x[1], 0, false); w0 = __builtin_amdgcn_cvt_pk_fp8_f32(x[2], x[3], w0, true); int w1 = __builtin_amdgcn_cvt_pk_fp8_f32(x[4], x[5], 0, false); w1 = __builtin_amdgcn_cvt_pk_fp8_f32(x[6], x[7], w1, true);
                *(GAS u32x2*)(d8 + e0) = (u32x2){(unsigned)w0, (unsigned)w1};
            } else { u32x4 o; o.x = cvt_pk_bf16(x[0], x[1]); o.y = cvt_pk_bf16(x[2], x[3]); o.z = cvt_pk_bf16(x[4], x[5]); o.w = cvt_pk_bf16(x[6], x[7]);
                *(GAS u32x4*)(dst + e0) = o; } }
    }
    if constexpr (ATT_PV8) {
        __syncthreads();
        LAS unsigned char* scr = (LAS unsigned char*)(F.lds + F.wave * 8192);
        const int key = F.lane, b32 = key >> 5, k5 = key & 31, khi = (k5 >> 2) & 1, rr = (k5 & 3) + 4 * (k5 >> 3), rho = khi * 32 + rr + 16 * b32;
        for (int it = F.gw; it < 4 * (T / 64); it += F.NGW) {
            const int kvh = it / (T / 64), tile = it % (T / 64);
            const bf16* src = VR + (size_t)(tile * 64 + key) * 512 + kvh * 128;
            u32x4 v[16];
#pragma unroll
            for (int c = 0; c < 16; ++c) v[c] = *(const GAS u32x4*)(src + 8 * c);
#pragma unroll
            for (int c = 0; c < 16; ++c) { const unsigned w4[4] = {v[c].x, v[c].y, v[c].z, v[c].w};
#pragma unroll
                for (int q = 0; q < 4; ++q) { const int pk = __builtin_amdgcn_cvt_pk_fp8_f32(bflo(w4[q]), bfhi(w4[q]), 0, false); const int d = 8 * c + 2 * q;
                    scr[d * 64 + rho] = (unsigned char)(pk & 0xff); scr[(d + 1) * 64 + rho] = (unsigned char)((pk >> 8) & 0xff); } }
            asm volatile("s_waitcnt lgkmcnt(0)" ::: "memory");
            unsigned char* dst = V8T + ((size_t)kvh * (T / 64) + tile) * 8192;
#pragma unroll
            for (int i = 0; i < 8; ++i) { const u32x4 o = *(const LAS u32x4*)(scr + (F.lane + 64 * i) * 16); *(GAS u32x4*)(dst + (F.lane + 64 * i) * 16) = o; }
            asm volatile("s_waitcnt lgkmcnt(0)" ::: "memory");
        }
    }
}

__device__ __forceinline__ void attn_phase(Frame& F, const bf16* QB, const bf16* KB, const bf16* VB, bf16* O, const unsigned char* V8T) {
    for (int i = 0;; ++i) {
        const int u = i * F.G + F.vcu; if (u >= 1040) break;
        int h, qb, seq; long krow0;
        if (u < 1024) { h = u >> 6; qb = u & 63; seq = T; krow0 = 0; } else { h = u - 1024; qb = 64; seq = CTX; krow0 = SEQ; }
        const int kvh = h >> 2; const long qrow0 = (long)qb * 256;
        if constexpr (ATT_PV8) att::attn_dense_body_f8pv<att::bf16>((const unsigned char*)QB + qrow0 * 2048 + h * 128, (const unsigned char*)KB + krow0 * 512 + kvh * 128, V8T + ((size_t)kvh * (T / 64) + krow0 / 64) * 8192,
                                                   (att::bf16*)O + qrow0 * 2048 + h * 128, seq, (char*)F.lds);
        else if constexpr (ATT_FP8) att::attn_dense_body_f8<att::bf16>((const unsigned char*)QB + qrow0 * 2048 + h * 128, (const unsigned char*)KB + krow0 * 512 + kvh * 128, (const att::bf16*)VB + krow0 * 512 + kvh * 128,
                                                   (att::bf16*)O + qrow0 * 2048 + h * 128, seq, (char*)F.lds);
        else att::attn_dense_body<att::bf16, att::bf16>((const att::bf16*)QB + qrow0 * 2048 + h * 128, (const att::bf16*)KB + krow0 * 512 + kvh * 128, (const att::bf16*)VB + krow0 * 512 + kvh * 128,
                                                   (att::bf16*)O + qrow0 * 2048 + h * 128, seq, (char*)F.lds);
        __syncthreads();
    }
}
__device__ __forceinline__ void ssm_z_phase(Frame& F, const bf16* H, const float* dskip, const bf16* Yd, bf16* Z) {
    const size_t n = (size_t)SEQ * D;
    const int gt = F.gw * 64 + F.lane, c8 = (gt & 255) * 8, r0 = gt >> 8, rstep = (F.NGW * 64) >> 8;
    const f32x4 d0 = *(const GAS f32x4*)(dskip + c8), d1 = *(const GAS f32x4*)(dskip + c8 + 4);
    for (int t0 = r0; t0 < SEQ; t0 += 4 * rstep) {
        u32x4 hv[4], ya[4], yb[4];
#pragma unroll
        for (int i = 0; i < 4; ++i) { const int t = t0 + i * rstep; const size_t e0 = (size_t)(t < SEQ ? t : SEQ - 1) * D + c8;
            hv[i] = *(const GAS u32x4*)(H + e0); ya[i] = __builtin_nontemporal_load((const GAS u32x4*)(Yd + e0)); yb[i] = __builtin_nontemporal_load((const GAS u32x4*)(Yd + n + e0)); }
#pragma unroll
        for (int i = 0; i < 4; ++i) { const int t = t0 + i * rstep; if (t >= SEQ) break; const size_t e0 = (size_t)t * D + c8;
            const u32x4 a = ya[i], b = yb[i]; const u32x4 h = hv[i];
            const f32x4 y0 = (f32x4){bflo(a.x) + bflo(b.x), bfhi(a.x) + bfhi(b.x), bflo(a.y) + bflo(b.y), bfhi(a.y) + bfhi(b.y)}, y1 = (f32x4){bflo(a.z) + bflo(b.z), bfhi(a.z) + bfhi(b.z), bflo(a.w) + bflo(b.w), bfhi(a.w) + bfhi(b.w)};
            float z[8] = {d0.x * bflo(h.x) + y0.x, d0.y * bfhi(h.x) + y0.y, d0.z * bflo(h.y) + y0.z, d0.w * bfhi(h.y) + y0.w,
                          d1.x * bflo(h.z) + y1.x, d1.y * bfhi(h.z) + y1.y, d1.z * bflo(h.w) + y1.z, d1.w * bfhi(h.w) + y1.w};
#pragma unroll
            for (int e = 0; e < 8; ++e) z[e] = gelu_tanh_f(z[e]);
            if constexpr (GLU_FP8) { int w0 = __builtin_amdgcn_cvt_pk_fp8_f32(z[0], z[1], 0, false); w0 = __builtin_amdgcn_cvt_pk_fp8_f32(z[2], z[3], w0, true); int w1 = __builtin_amdgcn_cvt_pk_fp8_f32(z[4], z[5], 0, false); w1 = __builtin_amdgcn_cvt_pk_fp8_f32(z[6], z[7], w1, true);
                *(GAS u32x2*)((unsigned char*)Z + e0) = (u32x2){(unsigned)w0, (unsigned)w1}; }
            else { u32x4 o; o.x = cvt_pk_bf16(z[0], z[1]); o.y = cvt_pk_bf16(z[2], z[3]); o.z = cvt_pk_bf16(z[4], z[5]); o.w = cvt_pk_bf16(z[6], z[7]);
                *(GAS u32x4*)(Z + e0) = o; } }
    }
}
struct EpiGlu {
    static constexpr bool PERM = true;
    bf16* X; const float* glu_b; const float* g1; float sc;
    __device__ __forceinline__ void operator()(const AccT& acc, const Unit& u, int wr, int wc, int fr, int fq) const {
        const int col0 = u.pn * 128 + wc * 32 + 8 * fq;
        f32x4 ba[2], bg[2], gv[2];
#pragma unroll
        for (int n = 0; n < 2; ++n) { ba[n] = *(const GAS f32x4*)(glu_b + col0 + n * 4); bg[n] = *(const GAS f32x4*)(glu_b + D + col0 + n * 4); gv[n] = *(const GAS f32x4*)(g1 + col0 + n * 4); }
#pragma unroll
        for (int ai = 0; ai < 2; ++ai)
#pragma unroll
            for (int m = 0; m < 4; ++m) { bf16* rowp = X + ((size_t)u.pm * 256 + ai * 128 + wr * 64 + m * 16 + fr) * D + col0;
                const u32x4 w = *(const GAS u32x4*)rowp; f32x4 r[2] = {(f32x4){bflo(w.x), bfhi(w.x), bflo(w.y), bfhi(w.y)}, (f32x4){bflo(w.z), bfhi(w.z), bflo(w.w), bfhi(w.w)}};
#pragma unroll
                for (int n = 0; n < 2; ++n) { const f32x4 av = acc[ai][0][m][n] * sc + ba[n], gg = acc[ai][1][m][n] * sc + bg[n];
                    f32x4 sg; sg.x = sigm_f(gg.x); sg.y = sigm_f(gg.y); sg.z = sigm_f(gg.z); sg.w = sigm_f(gg.w);
                    r[n] = r[n] + gv[n] * av * sg; }
                u32x4 o; o.x = cvt_pk_bf16(r[0].x, r[0].y); o.y = cvt_pk_bf16(r[0].z, r[0].w); o.z = cvt_pk_bf16(r[1].x, r[1].y); o.w = cvt_pk_bf16(r[1].z, r[1].w);
                *(GAS u32x4*)rowp = o; }
    }
};
}
namespace mk {
constexpr int SSM_RA = 0, SSM_BST_LD = 528, SSM_CST_LD = 272, SSM_KM = 69632, SSM_TBL = 78336, SSM_TE = 90624;
__device__ __forceinline__ f32x2 cmul(f32x2 a, f32x2 b) { return (f32x2){a.x * b.x - a.y * b.y, a.x * b.y + a.y * b.x}; }
__device__ __forceinline__ float dpp_shr(float v, int o) {
    const int x = __builtin_bit_cast(int, v); int r;
    if (o == 1) r = __builtin_amdgcn_update_dpp(0, x, 0x111, 0xf, 0xf, true); else if (o == 2) r = __builtin_amdgcn_update_dpp(0, x, 0x112, 0xf, 0xf, true);
    else if (o == 4) r = __builtin_amdgcn_update_dpp(0, x, 0x114, 0xf, 0xf, true); else r = __builtin_amdgcn_update_dpp(0, x, 0x118, 0xf, 0xf, true);
    return __builtin_bit_cast(float, r);
}
__device__ __forceinline__ int ssm_row(int s, int d) {
    if (s < CTX) return SEQ + (d ? CTX - 1 - s : s);
    const int li = s - CTX; return d ? SEQ - 1 - li : li;
}
template <int XS = 0>
__device__ __forceinline__ void ssm_mfma_phase(Frame& F, const bf16* H, const float* a_re, const float* a_im, const float* log_dt,
                                               const float* b_re, const float* b_im, const float* c_re, const float* c_im, bf16* Yd, float* SS) {
    LAS unsigned char* lds = F.lds;
    LAS f32x2* TBL = (LAS f32x2*)(lds + SSM_TBL);
    LAS float* TE = (LAS float*)(lds + SSM_TE);
    const int tid = F.tid, lane = F.lane, wave = F.wave, p = tid & 63, l15 = lane & 15, q = lane >> 4;
    for (int dg = F.vcu; dg < 256; dg += F.G) {
        const int d = dg >> 7, g = dg & 127;
        const int gp = dg * 64 + p;
        const float dt = __expf(log_dt[dg]);
        const float are = a_re[gp], aim = a_im[gp];
        f32x2 ab; { const float mag = __expf(are * dt); float sn, cs; sincosf(aim * dt, &sn, &cs); ab = (f32x2){mag * cs, mag * sn}; }
        f32x2 ff; { const float nr = ab.x - 1.f, ni = ab.y, den = are * are + aim * aim; ff = (f32x2){(nr * are + ni * aim) / den, (ni * are - nr * aim) / den}; }
        __syncthreads();
        if (wave == 0) {
            TBL[0 * 64 + p] = ab; TBL[1 * 64 + p] = ff;
            const f32x2 a2 = cmul(ab, ab), a4 = cmul(a2, a2), a8 = cmul(a4, a4), a16 = cmul(a8, a8), a32 = cmul(a16, a16), a64 = cmul(a32, a32), a128 = cmul(a64, a64), a256 = cmul(a128, a128);
            TBL[2 * 64 + p] = a8; TBL[3 * 64 + p] = a16; TBL[4 * 64 + p] = a32; TBL[5 * 64 + p] = a64; TBL[6 * 64 + p] = a128; TBL[7 * 64 + p] = a256;
            f32x2 t = (f32x2){1.f, 0.f};
#pragma unroll 1
            for (int j = 0; j < 16; ++j) { TBL[(8 + j) * 64 + p] = t; t = cmul(t, a16); }
        }
        __syncthreads();
        {
            const int sgrp = tid >> 6;
            f32x2 bbv[16];
#pragma unroll
            for (int c4 = 0; c4 < 4; ++c4) { const f32x4 br = *(const GAS f32x4*)(b_re + (size_t)gp * 16 + 4 * c4), bi = *(const GAS f32x4*)(b_im + (size_t)gp * 16 + 4 * c4);
                bbv[4 * c4 + 0] = cmul(ff, (f32x2){br.x, bi.x}); bbv[4 * c4 + 1] = cmul(ff, (f32x2){br.y, bi.y}); bbv[4 * c4 + 2] = cmul(ff, (f32x2){br.z, bi.z}); bbv[4 * c4 + 3] = cmul(ff, (f32x2){br.w, bi.w}); }
#pragma unroll
            for (int h = 0; h < 2; ++h) { const int sg = 2 * sgrp + h; f32x2 pw = (f32x2){1.f, 0.f};
#pragma unroll 1
                for (int i = 0; i < 15 - sg; ++i) pw = cmul(pw, ab);
                LAS bf16* r0 = (LAS bf16*)(lds + SSM_RA + (2 * p) * SSM_BST_LD) + sg * 16; LAS bf16* r1 = (LAS bf16*)(lds + SSM_RA + (2 * p + 1) * SSM_BST_LD) + sg * 16;
#pragma unroll
                for (int c = 0; c < 16; ++c) { const f32x2 v = cmul(pw, bbv[c]); r0[c] = (bf16)(cvt_pk_bf16(v.x, 0.f) & 0xffffu); r1[c] = (bf16)(cvt_pk_bf16(v.y, 0.f) & 0xffffu); } }
            const int pair = tid & 255, half = tid >> 8, cp = pair >> 4, cc = pair & 15;
            float accl[8] = {0.f, 0.f, 0.f, 0.f, 0.f, 0.f, 0.f, 0.f};
#pragma unroll 1
            for (int p0 = 0; p0 < 64; p0 += 8) {
                f32x2 cv[8], bv[8];
#pragma unroll
                for (int i8 = 0; i8 < 8; ++i8) { const int pp = p0 + i8; const size_t ci = ((size_t)dg * 16 + cp) * 64 + pp, bi_ = ((size_t)dg * 64 + pp) * 16 + cc;
                    cv[i8] = (f32x2){c_re[ci], c_im[ci]}; bv[i8] = (f32x2){b_re[bi_], b_im[bi_]}; }
#pragma unroll
                for (int i8 = 0; i8 < 8; ++i8) { const int pp = p0 + i8;
                    const f32x2 ap = TBL[pp], fp = TBL[64 + pp], a8p = TBL[128 + pp];
                    f32x2 t = cmul(cv[i8], cmul(fp, bv[i8]));
                    if (half) t = cmul(t, a8p);
#pragma unroll
                    for (int i = 0; i < 8; ++i) { accl[i] += t.x; t = cmul(t, ap); } }
            }
            LAS bf16* km = (LAS bf16*)(lds + SSM_KM);
#pragma unroll
            for (int i = 0; i < 8; ++i) km[(8 * half + i + 1) * 256 + pair] = (bf16)(cvt_pk_bf16(accl[i], 0.f) & 0xffffu);
            if (tid < 256) km[tid] = 0;
        }
        __syncthreads();
        for (int ct = (XS & 1) ? 65 : wave; ct < 65; ct += 8) {
            bf16x8 uf[8];
#pragma unroll
            for (int ks = 0; ks < 8; ++ks) { const int s = (ct * 16 + l15) * 16 + 2 * ks + (q >> 1); uf[ks] = *(const GAS bf16x8*)(H + (size_t)ssm_row(s, d) * D + g * 16 + 8 * (q & 1)); }
            f32x4 acc[8];
#pragma unroll
            for (int mt = 0; mt < 8; ++mt) { acc[mt] = (f32x4){0.f, 0.f, 0.f, 0.f};
#pragma unroll
                for (int ks = 0; ks < 8; ++ks) { const bf16x8 af = *(const LAS bf16x8*)(lds + SSM_RA + (16 * mt + l15) * SSM_BST_LD + (32 * ks + 8 * q) * 2);
                    acc[mt] = __builtin_amdgcn_mfma_f32_16x16x32_bf16(af, uf[ks], acc[mt], 0, 0, 0); } }
#pragma unroll
            for (int oi = 0; oi < 4; ++oi) {
#pragma unroll
                for (int mt = 0; mt < 8; ++mt) { const f32x4 pw = *(const LAS f32x4*)(TBL + (3 + oi) * 64 + 8 * mt + 2 * q);
                    const float t0 = dpp_shr(acc[mt].x, 1 << oi), t1 = dpp_shr(acc[mt].y, 1 << oi), t2 = dpp_shr(acc[mt].z, 1 << oi), t3 = dpp_shr(acc[mt].w, 1 << oi);
                    acc[mt].x += pw.x * t0 - pw.y * t1; acc[mt].y += pw.x * t1 + pw.y * t0; acc[mt].z += pw.z * t2 - pw.w * t3; acc[mt].w += pw.z * t3 + pw.w * t2; }
            }
            float* ss = SS + (((size_t)dg * 65 + ct) * 8) * 256 + l15 * 16 + 4 * q;
#pragma unroll
            for (int mt = 0; mt < 8; ++mt) { *(GAS f32x4*)(ss + 256 * mt) = acc[mt]; if (l15 == 15) *(LAS f32x4*)(TE + ct * 128 + 16 * mt + 4 * q) = acc[mt]; }
        }
        asm volatile("s_waitcnt vmcnt(0)" ::: "memory");
        __syncthreads();
        {
            const int tgrp = tid >> 6;
#pragma unroll
            for (int h = 0; h < 2; ++h) { const int tau = 2 * tgrp + h; f32x2 pw = ab;
#pragma unroll 1
                for (int i = 0; i < tau; ++i) pw = cmul(pw, ab);
                f32x2 cvv[16];
#pragma unroll
                for (int c = 0; c < 16; ++c) { const size_t ci = ((size_t)dg * 16 + c) * 64 + p; cvv[c] = (f32x2){c_re[ci], c_im[ci]}; }
#pragma unroll
                for (int c = 0; c < 16; ++c) { const f32x2 v = cmul(cvv[c], pw);
                    *(LAS unsigned*)(lds + SSM_RA + (tau * 16 + c) * SSM_CST_LD + (2 * p) * 2) = cvt_pk_bf16(v.x, -v.y); } }
        }
        if (wave == 0) {
            const f32x2 a256 = TBL[7 * 64 + p]; f32x2 c = (f32x2){0.f, 0.f};
#pragma unroll 1
            for (int ct = 0; ct < 65; ++ct) { LAS f32x2* te = (LAS f32x2*)(TE + ct * 128) + p; const f32x2 e = *te; *te = c; c = cmul(a256, c) + e; }
        }
        __syncthreads();
        const int chl = 4 * (((l15 >> 2) & 1) * 2 + ((l15 >> 3) & 1)) + (l15 & 3);
        const int kbase = SSM_KM + (-(q >> 1) * 256 + chl * 16 + 8 * (q & 1)) * 2, cbase = SSM_RA + chl * SSM_CST_LD + 16 * q;
        bf16* Y = Yd + (size_t)d * SEQ * D;
        for (int ct = (XS & 2) ? 65 : 1 + wave; ct < 65; ct += 8) {
            bf16x8 uf[8];
#pragma unroll
            for (int ks = 0; ks < 8; ++ks) { const int s = (ct * 16 + l15) * 16 + 2 * ks + (q >> 1); uf[ks] = *(const GAS bf16x8*)(H + (size_t)ssm_row(s, d) * D + g * 16 + 8 * (q & 1)); }
            bf16x8 sf[4];
            const float msk = l15 ? 1.f : 0.f;
            const int cprev = ct * 16 + l15 - 1;
            const float* sl = SS + (((size_t)dg * 65 + (cprev >> 4)) * 8) * 256 + (cprev & 15) * 16 + 8 * (q & 1);
#pragma unroll
            for (int ks = 0; ks < 4; ++ks) {
                const int p0 = 16 * ks + 4 * q;
                const f32x4 s0 = __builtin_nontemporal_load((const GAS f32x4*)(sl + (2 * ks + (q >> 1)) * 256)), s1 = __builtin_nontemporal_load((const GAS f32x4*)(sl + (2 * ks + (q >> 1)) * 256 + 4));
                const f32x4 c0 = *(const LAS f32x4*)(TE + ct * 128 + 2 * p0), c1 = *(const LAS f32x4*)(TE + ct * 128 + 2 * p0 + 4);
                const f32x4 w0 = *(const LAS f32x4*)(TBL + (8 + l15) * 64 + p0), w1 = *(const LAS f32x4*)(TBL + (8 + l15) * 64 + p0 + 2);
                const float v0 = w0.x * c0.x - w0.y * c0.y + msk * s0.x, v1 = w0.x * c0.y + w0.y * c0.x + msk * s0.y, v2 = w0.z * c0.z - w0.w * c0.w + msk * s0.z, v3 = w0.z * c0.w + w0.w * c0.z + msk * s0.w;
                const float v4 = w1.x * c1.x - w1.y * c1.y + msk * s1.x, v5 = w1.x * c1.y + w1.y * c1.x + msk * s1.y, v6 = w1.z * c1.z - w1.w * c1.w + msk * s1.z, v7 = w1.z * c1.w + w1.w * c1.z + msk * s1.w;
                u32x4 w; w.x = cvt_pk_bf16(v0, v1); w.y = cvt_pk_bf16(v2, v3); w.z = cvt_pk_bf16(v4, v5); w.w = cvt_pk_bf16(v6, v7); sf[ks] = __builtin_bit_cast(bf16x8, w);
            }
#pragma unroll
            for (int tp = 0; tp < 8; ++tp) {
                unsigned wx[2], wy[2];
#pragma unroll
                for (int h = 0; h < 2; ++h) { const int tau = 2 * tp + h;
                    f32x4 acc = (f32x4){0.f, 0.f, 0.f, 0.f};
#pragma unroll
                    for (int ks = 0; ks <= (tau >> 1); ++ks) { const bf16x8 af = *(const LAS bf16x8*)(lds + kbase + (tau - 2 * ks + 1) * 512); acc = __builtin_amdgcn_mfma_f32_16x16x32_bf16(af, uf[ks], acc, 0, 0, 0); }
#pragma unroll
                    for (int ks = 0; ks < 4; ++ks) { const bf16x8 af = *(const LAS bf16x8*)(lds + cbase + tau * (16 * SSM_CST_LD) + ks * 64); acc = __builtin_amdgcn_mfma_f32_16x16x32_bf16(af, sf[ks], acc, 0, 0, 0); }
                    wx[h] = pg::cvt_pk_c(acc.x, acc.y); wy[h] = pg::cvt_pk_c(acc.z, acc.w); }
                const auto r0 = __builtin_amdgcn_permlane32_swap(wx[0], wx[1], false, false), r1 = __builtin_amdgcn_permlane32_swap(wy[0], wy[1], false, false);
                const int s = (ct * 16 + l15) * 16 + 2 * tp + (q >> 1);
                *(GAS u32x4*)(Y + (size_t)ssm_row(s, d) * D + g * 16 + 8 * (q & 1)) = (u32x4){r0[0], r1[0], r0[1], r1[1]};
            }
        }
    }
}
}
namespace mk {
constexpr int NPH = 32;
enum { PH_PRO = 0, PH_N0 = 1, PH_L0 = 2, PH_M0 = 6, PH_L1 = 10, PH_M1 = 13, PH_L2 = 17, PH_M2 = 21, PH_L3 = 25, PH_M3 = 28 };

__global__ void __launch_bounds__(NTHR, 2) mk_fwd(Args args) {
    extern __shared__ __attribute__((aligned(16))) unsigned char lds_raw[];
    Frame F;
    F.lds = (LAS unsigned char*)lds_raw; F.MISC = (volatile LAS unsigned*)(F.lds + MISC_OFF);
    F.tid = threadIdx.x; F.lane = F.tid & 63; F.wave = __builtin_amdgcn_readfirstlane(F.tid >> 6);
    F.G = gridDim.x; { const int bx = blockIdx.x; F.vcu = (F.G % 8 == 0) ? (bx % 8) * (F.G / 8) + bx / 8 : bx; }
    F.gw = F.vcu * NWAVES + F.wave; F.NGW = F.G * NWAVES;
    F.ws = args.ws; F.ctl = (unsigned*)(args.ws + WS_CTL); F.ar = args.ws + WS_ARENA;
    for (int u = F.tid; u < (LDS_BYTES - MISC_OFF) / 4; u += NTHR) ((LAS unsigned*)(F.lds + MISC_OFF))[u] = 0u;
    __syncthreads();
    const int lo = args.ph_lo, hi = args.ph_hi;
    XcdBarrier bar; bar.bar = F.ctl + CW_BAR; bar.x = 0; bar.st = nullptr;
    if (hi - lo > 1) bar = xcd_barrier_post(F.ctl + CW_BAR, F.MISC);
#ifdef MK_ONLY
#define IN(k) ((k) == MK_ONLY && lo <= (k) && (k) < hi)
#else
#define IN(k) (lo <= (k) && (k) < hi)
#endif
#define SEAM(k) do { if (IN((k) + 1)) xcd_barrier(bar); } while (0)
    unsigned char* ws = F.ws; unsigned char* ar = F.ar;
    bf16* X = (bf16*)(ws + WS_X); bf16* H = (bf16*)(ws + WS_H); bf16* H2 = (bf16*)(ws + WS_H2);
    const float* MOD = (const float*)(F.ctl + CW_MOD);
    int* REC = (int*)(ws + WS_REC); float* GATE = (float*)(ws + WS_GATE); int* TOKL = (int*)(ws + WS_TOKL);
    bf16* ACT = (bf16*)(ws + WS_ACT); bf16* YB = (bf16*)(ws + WS_YB);
#define GEFF(U) (((U) + (((U) + F.G - 1) / F.G) - 1) / (((U) + F.G - 1) / F.G))
#define BG(lo, hi, geff) do { if (F.vcu >= (geff)) convert_items(F, args, (lo), (hi), (F.vcu - (geff)) * NWAVES + F.wave, (F.G - (geff)) * NWAVES); } while (0)
#define MODL(l) (MOD + (size_t)(l) * 2 * 6 * D)
    const float* XIN_L = args.xin ? args.xin : args.in[0]; const float* XIN_C = args.xin ? args.xin + (size_t)SEQ * D : args.in[2];
#define G1LAT(l) (MODL(l) + 2 * D)
#define G1CTX(l) (MODL(l) + 6 * D + 2 * D)

    if (IN(PH_PRO)) { p0_prologue(F, args); SEAM(PH_PRO); }

#define MOE_BLOCK(l, base, nrows, LASTF, H8F) \
    if (IN((base) + 0)) { router_phase(F, X, args.in[7] + (size_t)(l) * D, MODL(l), args.in[30] + (size_t)(l) * D * NE, args.in[31] + (size_t)(l) * NE, H2, F.ctl + CW_CNT + (l) * 2048, TOKL, REC, GATE, (nrows)); SEAM((base) + 0); } \
    if (IN((base) + 1)) { moe_tables(F, F.ctl + CW_CNT + (l) * 2048); Moe1Prob P; P.init(H2, ws + WS_WT_W1 + (size_t)(l) * NE * 2 * DE * D * MOE_EB, TOKL, F); \
        EpiMoe1 E{ACT, args.in[33] + (size_t)(l) * NE * 2 * DE}; pg::gemm_phase<EpiMoe1, Moe1Prob, true, MOE_FP8>(F.lds, P, E); SEAM((base) + 1); } \
    if (IN((base) + 2)) { moe_tables(F, F.ctl + CW_CNT + (l) * 2048); Moe2Prob P; P.init(ACT, ws + WS_WT_W2 + (size_t)(l) * NE * D * DE * MOE_EB, F); \
        EpiMoe2 E{YB, args.in[35] + (size_t)(l) * NE * D}; pg::gemm_phase<EpiMoe2, Moe2Prob, false, MOE_FP8>(F.lds, P, E); SEAM((base) + 2); } \
    if (IN((base) + 3)) { moe_tables(F, F.ctl + CW_CNT + (l) * 2048); \
        combine_phase<LASTF, H8F>(F, X, YB, REC, GATE, MODL(l), (nrows), args.out, args.in[6] + (size_t)(((l) + 1) & 3) * D, MODL(((l) + 1) & 3), H); SEAM((base) + 3); }

    if (IN(PH_N0)) { norm_phase(F, XIN_L, XIN_C, args.in[6], MODL(0), H, T); SEAM(PH_N0); }
    if (IN(PH_L0 + 0)) {
        { CdftProb P; P.init(ws + WS_DT, H, F); EpiCdft E{(bf16*)(ar + AR_L1)}; pg::gemm_phase<EpiCdft, CdftProb, false>(F.lds, P, E); }
        { CdftCtxProb P; P.init(ws + WS_DT, H, F); EpiCdftCtx E{(bf16*)(ar + AR_LC)}; pg::gemm_phase<EpiCdftCtx, CdftCtxProb, false>(F.lds, P, E); }
        SEAM(PH_L0 + 0); }
    if (IN(PH_L0 + 1)) {
        { Step1Prob P; P.init(ws + WS_DM1, ar + AR_L1, F); EpiStep1 E{(bf16*)(ar + AR_L2)}; pg::gemm_phase<EpiStep1, Step1Prob, false>(F.lds, P, E); }
        { SeqCtxProb P; P.init(ws + WS_DM256, ar + AR_LC, F); EpiSeqCtx E{(bf16*)(ar + AR_F)}; pg::gemm_phase<EpiSeqCtx, SeqCtxProb, false>(F.lds, P, E); }
        SEAM(PH_L0 + 1); }
    if (IN(PH_L0 + 2)) { Step2Prob P; P.init(ws + WS_DM2, ar + AR_L2, F); EpiStep2 E{(bf16*)(ar + AR_F), 1.f / 2048.f}; pg::gemm_phase<EpiStep2, Step2Prob, false>(F.lds, P, E); SEAM(PH_L0 + 2); }
    if (IN(PH_L0 + 3)) { const int ge = GEFF(MT * 8); DenseProb P; P.init(ar + AR_F, ws + WS_WT_F, D, D, D, MT, 8, F, ge); EpiResid<true> E{X, args.in[9], G1LAT(0), G1CTX(0), XIN_L, XIN_C}; pg::gemm_phase<EpiResid<true>, DenseProb, false>(F.lds, P, E);
        BG(tr_moe_lo(0), tr_moe_lo(0) + (TR_NL / 64) * BG_F0, ge); SEAM(PH_L0 + 3); }
    MOE_BLOCK(0, PH_M0, T, false, CIN_FP8)
    if (IN(PH_L1 + 0)) { const int ge = GEFF(MT * 24); constexpr int kd = CIN_FP8 ? D / 2 : D; DenseProbC<kd, MT, 24> P; P.init(H, ws + WS_WT_CIN, F, ge); EpiConvIn E{(bf16*)(ar + AR_GB), (bf16*)(ar + AR_S), CIN_FP8 ? 1.f / D8_WSCALE : 1.f}; pg::gemm_phase<EpiConvIn, DenseProbC<kd, MT, 24>, false, CIN_FP8>(F.lds, P, E);
        BG(tr_moe_lo(1), tr_moe_lo(1) + (TR_NL / 64) * BG_F1A, ge); SEAM(PH_L1 + 0); }
    if (IN(PH_L1 + 1)) { conv_phase(F, (const bf16*)(ar + AR_GB), (const bf16*)(ar + AR_S), args.in[11], args.in[12], (bf16*)(ar + AR_A2)); SEAM(PH_L1 + 1); }
    if (IN(PH_L1 + 2)) { const int ge = GEFF(MT * 8); DenseProb P; P.init(ar + AR_A2, ws + WS_WT_COUT, D, D, D, MT, 8, F, ge); EpiResid<false> E{X, nullptr, G1LAT(1), G1CTX(1), X, X + (size_t)SEQ * D}; pg::gemm_phase<EpiResid<false>, DenseProb, false>(F.lds, P, E);
        BG(tr_moe_lo(1) + (TR_NL / 64) * BG_F1A, tr_moe_lo(1) + (TR_NL / 64) * BG_F1B, ge); SEAM(PH_L1 + 2); }
    MOE_BLOCK(1, PH_M1, T, false, QKV_FP8)
    if (IN(PH_L2 + 0)) { const int ge = GEFF(MT * 12); constexpr int kd = QKV_FP8 ? D / 2 : D; DenseProbC<kd, MT, 12> P; P.init(H, ws + WS_WT_QKV, F, ge); EpiQKV E{(bf16*)(ar + AR_QR), (bf16*)(ar + AR_KR), (bf16*)(ar + AR_VR), QKV_FP8 ? 1.f / D8_WSCALE : 1.f}; pg::gemm_phase<EpiQKV, DenseProbC<kd, MT, 12>, false, QKV_FP8>(F.lds, P, E);
        BG(tr_moe_lo(2), tr_moe_lo(2) + (TR_NL / 64) * BG_F2A, ge); SEAM(PH_L2 + 0); }
    if (IN(PH_L2 + 1)) { qkv_prep_phase(F, (const bf16*)(ar + AR_QR), (const bf16*)(ar + AR_KR), (const bf16*)(ar + AR_VR), args.in[18], args.in[19], (bf16*)(ar + AR_QB), (bf16*)(ar + AR_KB), (bf16*)(ar + AR_VB), ar + AR_V8T); SEAM(PH_L2 + 1); }
    if (IN(PH_L2 + 2)) { attn_phase(F, (const bf16*)(ar + AR_QB), (const bf16*)(ar + AR_KB), (const bf16*)(ar + AR_VB), (bf16*)(ar + AR_O), ar + AR_V8T); SEAM(PH_L2 + 2); }
    if (IN(PH_L2 + 3)) { const int ge = GEFF(MT * 8); DenseProb P; P.init(ar + AR_O, ws + WS_WT_WO, D, D, D, MT, 8, F, ge); EpiResid<false> E{X, nullptr, G1LAT(2), G1CTX(2), X, X + (size_t)SEQ * D}; pg::gemm_phase<EpiResid<false>, DenseProb, false>(F.lds, P, E);
        BG(tr_moe_lo(2) + (TR_NL / 64) * BG_F2A, tr_moe_lo(2) + (TR_NL / 64) * BG_F2B, ge); SEAM(PH_L2 + 3); }
    MOE_BLOCK(2, PH_M2, T, false, false)
    if (IN(PH_L3 + 0)) { ssm_mfma_phase(F, H, args.in[20], args.in[21], args.in[22], args.in[23], args.in[24], args.in[25], args.in[26], (bf16*)(ar + AR_YD), (float*)(ar + AR_SS)); SEAM(PH_L3 + 0); }
    if (IN(PH_L3 + 1)) { ssm_z_phase(F, H, args.in[27], (const bf16*)(ar + AR_YD), (bf16*)(ar + AR_Z)); SEAM(PH_L3 + 1); }
    if (IN(PH_L3 + 2)) { constexpr int kd = GLU_FP8 ? D / 2 : D; DenseProbC<kd, SEQ / 256, 16> P; P.init(ar + AR_Z, ws + WS_WT_GLU, F); EpiGlu E{X, args.in[29], G1LAT(3), GLU_FP8 ? 1.f / D8_WSCALE : 1.f}; pg::gemm_phase<EpiGlu, DenseProbC<kd, SEQ / 256, 16>, false, GLU_FP8>(F.lds, P, E); SEAM(PH_L3 + 2); }
    MOE_BLOCK(3, PH_M3, SEQ, true, false)
#ifdef MK_EXP
    if (IN(51)) { read_items(F, args, tr_moe_lo(3), tr_moe_lo(4), F.gw, F.NGW); }
    if (IN(52)) { convert_items(F, args, tr_moe_lo(3), tr_moe_lo(4), F.gw, F.NGW); }
    if (IN(48)) { ssm_mfma_phase<1>(F, H, args.in[20], args.in[21], args.in[22], args.in[23], args.in[24], args.in[25], args.in[26], (bf16*)(ar + AR_YD), (float*)(ar + AR_SS)); }
    if (IN(49)) { ssm_mfma_phase<2>(F, H, args.in[20], args.in[21], args.in[22], args.in[23], args.in[24], args.in[25], args.in[26], (bf16*)(ar + AR_YD), (float*)(ar + AR_SS)); }
    if (IN(50)) { ssm_mfma_phase<3>(F, H, args.in[20], args.in[21], args.in[22], args.in[23], args.in[24], args.in[25], args.in[26], (bf16*)(ar + AR_YD), (float*)(ar + AR_SS)); }
    if (IN(45)) { router_phase<1>(F, X, args.in[7] + (size_t)3 * D, MODL(3), args.in[30] + (size_t)3 * D * NE, args.in[31] + (size_t)3 * NE, H2, F.ctl + CW_CNT + 3 * 2048, TOKL, REC, GATE, SEQ); }
    if (IN(46)) { router_phase<2>(F, X, args.in[7] + (size_t)3 * D, MODL(3), args.in[30] + (size_t)3 * D * NE, args.in[31] + (size_t)3 * NE, H2, F.ctl + CW_CNT + 3 * 2048, TOKL, REC, GATE, SEQ); }
    if (IN(47)) { router_phase<3>(F, X, args.in[7] + (size_t)3 * D, MODL(3), args.in[30] + (size_t)3 * D * NE, args.in[31] + (size_t)3 * NE, H2, F.ctl + CW_CNT + 3 * 2048, TOKL, REC, GATE, SEQ); }
    if (IN(40)) { moe_tables(F, F.ctl + CW_CNT + 3 * 2048); Moe1ProbHot P; P.init(H2, ws + WS_WT_W1 + (size_t)3 * NE * 2 * DE * D * MOE_EB, TOKL, F);
        EpiMoe1 E{ACT, args.in[33] + (size_t)3 * NE * 2 * DE}; pg::gemm_phase<EpiMoe1, Moe1ProbHot, true, MOE_FP8>(F.lds, P, E); }
    if (IN(41)) { moe_tables(F, F.ctl + CW_CNT + 3 * 2048); Moe1ProbHot P; P.init(H2, ws + WS_WT_W1 + (size_t)3 * NE * 2 * DE * D * MOE_EB, TOKL, F);
        EpiMoe1 E{ACT, args.in[33] + (size_t)3 * NE * 2 * DE}; pg::gemm_phase<EpiMoe1, Moe1ProbHot, true, MOE_FP8, 1>(F.lds, P, E); }
    if (IN(42)) { moe_tables(F, F.ctl + CW_CNT + 3 * 2048); Moe1ProbHot P; P.init(H2, ws + WS_WT_W1 + (size_t)3 * NE * 2 * DE * D * MOE_EB, TOKL, F);
        EpiMoe1 E{ACT, args.in[33] + (size_t)3 * NE * 2 * DE}; pg::gemm_phase<EpiMoe1, Moe1ProbHot, true, MOE_FP8, 3>(F.lds, P, E); }
    if (IN(43)) { moe_tables(F, F.ctl + CW_CNT + 3 * 2048); Moe1ProbHot P; P.init(H2, ws + WS_WT_W1 + (size_t)3 * NE * 2 * DE * D * MOE_EB, TOKL, F);
        EpiMoe1 E{ACT, args.in[33] + (size_t)3 * NE * 2 * DE}; pg::gemm_phase<EpiMoe1, Moe1ProbHot, true, MOE_FP8, 2>(F.lds, P, E); }
    if (IN(44)) { moe_tables(F, F.ctl + CW_CNT + 3 * 2048); Moe1ProbHot P; P.init(H2, ws + WS_WT_W1 + (size_t)3 * NE * 2 * DE * D * MOE_EB, TOKL, F);
        EpiMoe1 E{ACT, args.in[33] + (size_t)3 * NE * 2 * DE}; pg::gemm_phase<EpiMoe1, Moe1ProbHot, true, MOE_FP8, 14>(F.lds, P, E); }
#endif
#undef IN
#undef SEAM
#undef MOE_BLOCK
}

static int fast_grid() { static int g = 0; if (!g) { int dev = 0, cus = 0; if (hipGetDevice(&dev) != hipSuccess || hipDeviceGetAttribute(&cus, hipDeviceAttributeMultiprocessorCount, dev) != hipSuccess || cus <= 0) cus = 256; g = cus < 256 ? (cus >= 88 ? (cus / 8) * 8 : cus) : 256; } return g; }
static void launch_fast(void* const* d_in, float* out, unsigned char* ws, int lo, int hi, hipStream_t st, const float* xin = nullptr) {
    Args a{};
    for (int i = 0; i < 36; ++i) a.in[i] = (const float*)d_in[i];
    a.out = out; a.ws = ws; a.xin = xin; a.ph_lo = lo; a.ph_hi = hi;
    hipLaunchKernelGGL(mk_fwd, dim3(fast_grid()), dim3(NTHR), LDS_BYTES, st, a);
}
static void reset_bar(unsigned char* ws, hipStream_t st) { (void)hipMemsetAsync(ws + WS_CTL + (size_t)CW_BAR * 4, 0, (size_t)XCD_BAR_WORDS * 4, st); }
static int fast_setup() {
    static int ok = 0;
    if (!ok) { if (hipFuncSetAttribute((const void*)mk_fwd, hipFuncAttributeMaxDynamicSharedMemorySize, LDS_BYTES) != hipSuccess) { fprintf(stderr, "hipFuncSetAttribute(mk_fwd) failed\n"); return 0; } ok = 1; }
    return 1;
}
}
extern "C" void kernel_launch(void* const* d_in, const int* in_sizes, int n_in,
                              void* d_out, int out_size, void* d_ws, size_t ws_size,
                              hipStream_t stream) {
    if (!mk::fast_setup()) return;
    if (ws_size < mk::WS_FAST_END) { fprintf(stderr, "kernel_launch: workspace too small (%zu < %zu)\n", ws_size, (size_t)mk::WS_FAST_END); return; }
    (void)hipMemsetAsync((unsigned char*)d_ws + mk::WS_CTL, 0, mk::CTL_BYTES, stream);
    mk::launch_fast(d_in, (float*)d_out, (unsigned char*)d_ws, 0, mk::NPH, stream);
}
```
